# Optimizing an MI355X kernel written in HIP

```python
import math
import jax, jax.numpy as jnp
from jax import lax
import numpy as np

D_MODEL = 2048
BATCH = 1
SEQ = 16384
DEPTH = 1

CHUNK = 64
Q_BLOCK = 128
EPS = 1e-6

ATT_HEADS = 8
ATT_KV_HEADS = 2
HEAD_DIM = 128
ATT_WIDTH = ATT_HEADS * HEAD_DIM
KV_WIDTH = ATT_KV_HEADS * HEAD_DIM
IDX_HEADS = 16
IDX_DIM = 64
INDEX_TOPK = 256
ROPE_THETA = 500000.0
ROPE_FRACTION = 4

SSM_GROUP_CH = 16
SSM_GROUPS = 32
SSM_WIDTH = SSM_GROUPS * SSM_GROUP_CH
SSM_STATE = 64
DT_MIN = 0.001
DT_MAX = 0.1

N_BRANCH = 2
SPLITS = (ATT_WIDTH, KV_WIDTH, KV_WIDTH, ATT_WIDTH,
          IDX_HEADS * IDX_DIM, IDX_DIM, IDX_HEADS,
          SSM_WIDTH, SSM_WIDTH,
          N_BRANCH * D_MODEL)
IN_WIDTH = sum(SPLITS)

kernel_name = "hybrid_dsa_s5_gated_merge"


def rms_norm(x, g):
    xf = x.astype(jnp.float32)
    y = xf * lax.rsqrt(jnp.mean(xf * xf, axis=-1, keepdims=True) + EPS)
    return (y * g.astype(jnp.float32)).astype(x.dtype)


def partial_rotary(x, positions):
    rd = x.shape[-1] // ROPE_FRACTION
    half = rd // 2
    inv_freq = jnp.exp(-math.log(ROPE_THETA) * jnp.arange(half, dtype=jnp.float32) * (2.0 / rd))
    ang = positions.astype(jnp.float32)[..., None] * inv_freq
    cos = jnp.cos(ang)[:, :, None, :]
    sin = jnp.sin(ang)[:, :, None, :]
    xf = x.astype(jnp.float32)
    x1, x2 = xf[..., :half], xf[..., half:rd]
    rot = jnp.concatenate([x1 * cos - x2 * sin, x2 * cos + x1 * sin], axis=-1).astype(x.dtype)
    return jnp.concatenate([rot, x[..., rd:]], axis=-1)


def dsa_attention(q, k, v, q_idx, k_idx, w_idx):
    b, l = q.shape[:2]
    n_blk = l // Q_BLOCK
    topk = min(INDEX_TOPK, l // 4)
    grp = ATT_HEADS // ATT_KV_HEADS
    key_chunk = jnp.arange(l) // CHUNK

    def to_blocks(a):
        a = a.reshape((b, n_blk, Q_BLOCK) + a.shape[2:])
        return jnp.moveaxis(a, 1, 0)

    q_blocks = to_blocks(q.reshape(b, l, ATT_KV_HEADS, grp, HEAD_DIM))
    qi_blocks = to_blocks(q_idx)
    w_blocks = to_blocks(w_idx)
    gather = jax.vmap(lambda src, ids: src[ids])

    def one_block(args):
        q_blk, qi_blk, w_blk, blk = args
        q_chunk = (blk * Q_BLOCK + jnp.arange(Q_BLOCK)) // CHUNK
        admissible = key_chunk[None, :] <= q_chunk[:, None]
        logits = jnp.einsum("bqhd,bsd->bqhs", qi_blk, k_idx) * (IDX_DIM ** -0.5)
        score = jnp.einsum("bqhs,bqh->bqs", jax.nn.relu(logits), w_blk).astype(jnp.float32)
        score = jnp.where(admissible[None], score, -jnp.inf)
        _, sel = lax.top_k(score, topk)
        valid = (sel // CHUNK) <= q_chunk[None, :, None]
        k_sel = gather(k, sel)
        v_sel = gather(v, sel)
        s = jnp.einsum("bqhgd,bqkhd->bqhgk", q_blk, k_sel).astype(jnp.float32) * (HEAD_DIM ** -0.5)
        s = jnp.where(valid[:, :, None, None, :], s, -jnp.inf)
        p = jax.nn.softmax(s, axis=-1).astype(v.dtype)
        return jnp.einsum("bqhgk,bqkhd->bqhgd", p, v_sel)

    out = lax.map(one_block, (q_blocks, qi_blocks, w_blocks, jnp.arange(n_blk)))
    return jnp.moveaxis(out, 0, 1).reshape(b, l, ATT_WIDTH)


def s5_combine(e1, e2):
    a1r, a1i, b1r, b1i = e1
    a2r, a2i, b2r, b2i = e2
    return (a2r * a1r - a2i * a1i,
            a2r * a1i + a2i * a1r,
            a2r * b1r - a2i * b1i + b2r,
            a2r * b1i + a2i * b1r + b2i)


def s5_ssm(u, a_re, a_im, log_dt, b_re, b_im, c_re, c_im, d_skip):
    bsz, l = u.shape[:2]
    ug = u.reshape(bsz, l, SSM_GROUPS, SSM_GROUP_CH).astype(jnp.float32)
    dt = jnp.exp(log_dt.astype(jnp.float32))[:, None]
    ar = a_re.astype(jnp.float32)
    ai = a_im.astype(jnp.float32)
    mag = jnp.exp(ar * dt)
    lb_re = mag * jnp.cos(ai * dt)
    lb_im = mag * jnp.sin(ai * dt)
    den = ar * ar + ai * ai
    coef_re = ((lb_re - 1.0) * ar + lb_im * ai) / den
    coef_im = (lb_im * ar - (lb_re - 1.0) * ai) / den
    br = b_re.astype(jnp.float32)
    bi = b_im.astype(jnp.float32)
    bb_re = coef_re[..., None] * br - coef_im[..., None] * bi
    bb_im = coef_re[..., None] * bi + coef_im[..., None] * br
    bu_re = jnp.einsum("blgc,gpc->blgp", ug, bb_re)
    bu_im = jnp.einsum("blgc,gpc->blgp", ug, bb_im)
    a_full_re = jnp.broadcast_to(lb_re, bu_re.shape)
    a_full_im = jnp.broadcast_to(lb_im, bu_im.shape)
    _, _, x_re, x_im = lax.associative_scan(s5_combine, (a_full_re, a_full_im, bu_re, bu_im), axis=1)
    y = (jnp.einsum("blgp,gcp->blgc", x_re, c_re.astype(jnp.float32))
         - jnp.einsum("blgp,gcp->blgc", x_im, c_im.astype(jnp.float32))
         + d_skip.astype(jnp.float32) * ug)
    return y.reshape(bsz, l, SSM_WIDTH).astype(u.dtype)


def hybrid_layer(x, positions, g_norm, w_in, b_merge, a_re, a_im, log_dt, ssm_b_re, ssm_b_im,
                 ssm_c_re, ssm_c_im, ssm_d, w_glu, b_glu, w_att_out, w_ssm_out, w_out):
    bsz, l, _ = x.shape
    h = rms_norm(x, g_norm)
    proj = h @ w_in
    offsets = np.cumsum(SPLITS)[:-1].tolist()
    q, k, v, att_gate, q_idx, k_idx, w_idx, u, ssm_gate, merge = jnp.split(proj, offsets, axis=-1)

    q = partial_rotary(q.reshape(bsz, l, ATT_HEADS, HEAD_DIM), positions)
    k = partial_rotary(k.reshape(bsz, l, ATT_KV_HEADS, HEAD_DIM), positions)
    v = v.reshape(bsz, l, ATT_KV_HEADS, HEAD_DIM)
    q_idx = partial_rotary(q_idx.reshape(bsz, l, IDX_HEADS, IDX_DIM), positions)
    k_idx = partial_rotary(k_idx.reshape(bsz, l, 1, IDX_DIM), positions)[:, :, 0]
    w_idx = w_idx * (IDX_HEADS ** -0.5)
    att = dsa_attention(q, k, v, q_idx, k_idx, w_idx)
    y_a = (att * jax.nn.silu(att_gate)) @ w_att_out

    s = jax.nn.gelu(s5_ssm(u, a_re, a_im, log_dt, ssm_b_re, ssm_b_im, ssm_c_re, ssm_c_im, ssm_d))
    s = s * jax.nn.sigmoid(s @ w_glu + b_glu)
    y_b = (s * jax.nn.silu(ssm_gate)) @ w_ssm_out

    gates = jax.nn.sigmoid(merge + b_merge).reshape(bsz, l, N_BRANCH, D_MODEL)
    mixed = gates[:, :, 0] * y_a + gates[:, :, 1] * y_b
    return x + mixed @ w_out


def setup_inputs(seed: int = 0) -> dict:
    key = jax.random.key(seed)
    ks = jax.random.split(key, 20)
    f32 = jnp.float32

    def nrm(k, shape, scale):
        return jax.random.normal(k, shape, f32) * scale

    x = jax.random.normal(ks[0], (BATCH, SEQ, D_MODEL), f32)
    offset = jax.random.randint(ks[1], (BATCH, 1), 0, 4096, dtype=jnp.int32)
    positions = offset + jnp.arange(SEQ, dtype=jnp.int32)[None, :]
    g_norm = 1.0 + nrm(ks[2], (DEPTH, D_MODEL), 0.01)
    w_in = nrm(ks[3], (DEPTH, D_MODEL, IN_WIDTH), D_MODEL ** -0.5)
    b_merge = nrm(ks[4], (DEPTH, N_BRANCH * D_MODEL), 0.01)
    a_re = -0.5 + nrm(ks[5], (DEPTH, SSM_GROUPS, SSM_STATE), 0.01)
    a_im = (math.pi * jnp.arange(SSM_STATE, dtype=f32))[None, None, :] + nrm(ks[6], (DEPTH, SSM_GROUPS, SSM_STATE), 0.01)
    log_dt = jax.random.uniform(ks[7], (DEPTH, SSM_GROUPS), f32, math.log(DT_MIN), math.log(DT_MAX))
    ssm_b_re = nrm(ks[8], (DEPTH, SSM_GROUPS, SSM_STATE, SSM_GROUP_CH), (2 * SSM_GROUP_CH) ** -0.5)
    ssm_b_im = nrm(ks[9], (DEPTH, SSM_GROUPS, SSM_STATE, SSM_GROUP_CH), (2 * SSM_GROUP_CH) ** -0.5)
    ssm_c_re = nrm(ks[10], (DEPTH, SSM_GROUPS, SSM_GROUP_CH, SSM_STATE), SSM_STATE ** -0.5)
    ssm_c_im = nrm(ks[11], (DEPTH, SSM_GROUPS, SSM_GROUP_CH, SSM_STATE), SSM_STATE ** -0.5)
    ssm_d = nrm(ks[12], (DEPTH, SSM_GROUPS, SSM_GROUP_CH), 1.0)
    w_glu = nrm(ks[13], (DEPTH, SSM_WIDTH, SSM_WIDTH), SSM_WIDTH ** -0.5)
    b_glu = nrm(ks[14], (DEPTH, SSM_WIDTH), 0.01)
    w_att_out = nrm(ks[15], (DEPTH, ATT_WIDTH, D_MODEL), ATT_WIDTH ** -0.5)
    w_ssm_out = nrm(ks[16], (DEPTH, SSM_WIDTH, D_MODEL), SSM_WIDTH ** -0.5)
    w_out = nrm(ks[17], (DEPTH, D_MODEL, D_MODEL), D_MODEL ** -0.5)
    g_final = 1.0 + nrm(ks[18], (D_MODEL,), 0.01)
    return {"x": x, "positions": positions, "g_norm": g_norm, "w_in": w_in, "b_merge": b_merge,
            "a_re": a_re, "a_im": a_im, "log_dt": log_dt, "ssm_b_re": ssm_b_re, "ssm_b_im": ssm_b_im,
            "ssm_c_re": ssm_c_re, "ssm_c_im": ssm_c_im, "ssm_d": ssm_d, "w_glu": w_glu, "b_glu": b_glu,
            "w_att_out": w_att_out, "w_ssm_out": w_ssm_out, "w_out": w_out, "g_final": g_final}


def reference(x, positions, g_norm, w_in, b_merge, a_re, a_im, log_dt, ssm_b_re, ssm_b_im,
              ssm_c_re, ssm_c_im, ssm_d, w_glu, b_glu, w_att_out, w_ssm_out, w_out, g_final):
    for i in range(DEPTH):
        x = hybrid_layer(x, positions, g_norm[i], w_in[i], b_merge[i], a_re[i], a_im[i], log_dt[i],
                         ssm_b_re[i], ssm_b_im[i], ssm_c_re[i], ssm_c_im[i], ssm_d[i], w_glu[i], b_glu[i],
                         w_att_out[i], w_ssm_out[i], w_out[i])
    return rms_norm(x, g_final)
```

```cpp
#include <hip/hip_runtime.h>
#include <hip/hip_cooperative_groups.h>
#include <stdint.h>
#include <stdio.h>
namespace cg = cooperative_groups;

#ifndef MEGA
#define MEGA 0
#endif

typedef _Float16 half_t;
typedef _Float16 half8 __attribute__((ext_vector_type(8)));
typedef _Float16 half4 __attribute__((ext_vector_type(4)));
typedef _Float16 half2v __attribute__((ext_vector_type(2)));
typedef float f32x16 __attribute__((ext_vector_type(16)));
typedef float f32x4 __attribute__((ext_vector_type(4)));
typedef unsigned int u32x4 __attribute__((ext_vector_type(4)));

constexpr int L = 16384, D = 2048, NIN = 8784, NP = 8832;
constexpr int C_Q = 0, C_K = 1024, C_V = 1280, C_AG = 1536, C_QI = 2560, C_KI = 3584, C_U = 3648,
              C_SG = 4160, C_MG = 4672, C_WI = 8768;
constexpr int SMEM_BYTES = 73728;
constexpr int BAND = 2048;
constexpr int KP = 1024;
constexpr int NPHASE = 26;

struct Params {
  const float* x; const int* pos; const float* g_norm; const float* w_in; const float* b_merge;
  const float* a_re; const float* a_im; const float* log_dt; const float* b_re; const float* b_im;
  const float* c_re; const float* c_im; const float* ssm_d; const float* w_glu; const float* b_glu;
  const float* w_att_out; const float* w_ssm_out; const float* w_out; const float* g_final;
  float* out;
  half_t* proj; half_t* kidx; half_t* h; half_t* wt_in; half_t* wt_att; half_t* wt_glu; half_t* wt_ssm;
  half_t* wt_out; half_t* s1; half_t* sg; half_t* attg; half_t* cmT;
  float* cos128; float* sin128; float* cos64; float* sin64; float* lam; float* bb; float* E;
  unsigned short* sel;
};

__device__ __forceinline__ float wave_sum(float v) {
#pragma unroll
  for (int o = 32; o > 0; o >>= 1) v += __shfl_xor(v, o, 64);
  return v;
}
__device__ __forceinline__ float sigmoidf_(float x) { return 1.0f / (1.0f + __expf(-x)); }
__device__ __forceinline__ float siluf_(float x) { return x / (1.0f + __expf(-x)); }
__device__ __forceinline__ float gelu_tanh(float x) {
  float u = 0.7978845608028654f * (x + 0.044715f * x * x * x);
  float t = 1.0f - 2.0f / (__expf(2.0f * u) + 1.0f);
  return 0.5f * x * (1.0f + t);
}

constexpr int T0_NORM = L / 4;
constexpr int T0_WIN = (D / 64) * (NP / 64);
constexpr int T0_WATT = (1024 / 64) * (2048 / 64);
constexpr int T0_WGLU = (512 / 64) * (512 / 64);
constexpr int T0_WSSM = (512 / 64) * (2048 / 64);
constexpr int T0_WOUT = (2048 / 64) * (2048 / 64);
constexpr int T0_ROT = (L * 24) / 256;
constexpr int T0_SSM = 8;
constexpr int T0_TOTAL = T0_NORM + T0_WIN + T0_WATT + T0_WGLU + T0_WSSM + T0_WOUT + T0_ROT + T0_SSM;

__device__ __forceinline__ int remap_col(int np) {
  if (np < 3648) return np;
  if (np < 8768) return np + 16;
  if (np < 8784) return np - 8768 + 3648;
  return -1;
}

__device__ __forceinline__ void transpose_tile(const float* __restrict__ W, int K, int N, half_t* __restrict__ Wt,
                               int kt, int nt, bool remap, char* smem) {
  half_t* t = (half_t*)smem;
  const int tid = threadIdx.x;
#pragma unroll 4
  for (int i = 0; i < 16; ++i) {
    int e = tid + 256 * i;
    int kk = e >> 6, nn = e & 63;
    int np = nt * 64 + nn;
    int n = remap ? remap_col(np) : np;
    float v = (n >= 0) ? W[(size_t)(kt * 64 + kk) * N + n] : 0.0f;
    t[nn * 66 + kk] = (half_t)v;
  }
  __syncthreads();
#pragma unroll 4
  for (int i = 0; i < 8; ++i) {
    int e = tid + 256 * i;
    int nn = e >> 5, kp = e & 31;
    half2v v; v.x = t[nn * 66 + kp * 2]; v.y = t[nn * 66 + kp * 2 + 1];
    *(half2v*)(Wt + (size_t)(nt * 64 + nn) * K + kt * 64 + kp * 2) = v;
  }
  __syncthreads();
}

__device__ __forceinline__ void prep_task(const Params& P, int t, char* smem) {
  const int tid = threadIdx.x, lane = tid & 63, wave = tid >> 6;
  if (t < T0_NORM) {
    int row = t * 4 + wave;
    const float4* xr = (const float4*)(P.x + (size_t)row * D);
    float4 v[8]; float ss = 0.f;
#pragma unroll
    for (int j = 0; j < 8; ++j) { v[j] = xr[j * 64 + lane]; ss += v[j].x * v[j].x + v[j].y * v[j].y + v[j].z * v[j].z + v[j].w * v[j].w; }
    ss = wave_sum(ss);
    float sc = rsqrtf(ss * (1.0f / D) + 1e-6f);
    const float4* g4 = (const float4*)P.g_norm;
#pragma unroll
    for (int j = 0; j < 8; ++j) {
      float4 g = g4[j * 64 + lane];
      half4 o; o.x = (half_t)(v[j].x * sc * g.x); o.y = (half_t)(v[j].y * sc * g.y);
      o.z = (half_t)(v[j].z * sc * g.z); o.w = (half_t)(v[j].w * sc * g.w);
      *(half4*)(P.h + (size_t)row * D + (j * 64 + lane) * 4) = o;
    }
    return;
  }
  t -= T0_NORM;
  if (t < T0_WIN) { transpose_tile(P.w_in, D, NIN, P.wt_in, t % 32, t / 32, true, smem); return; }
  t -= T0_WIN;
  if (t < T0_WATT) { transpose_tile(P.w_att_out, 1024, 2048, P.wt_att, t % 16, t / 16, false, smem); return; }
  t -= T0_WATT;
  if (t < T0_WGLU) { transpose_tile(P.w_glu, 512, 512, P.wt_glu, t % 8, t / 8, false, smem); return; }
  t -= T0_WGLU;
  if (t < T0_WSSM) { transpose_tile(P.w_ssm_out, 512, 2048, P.wt_ssm, t % 8, t / 8, false, smem); return; }
  t -= T0_WSSM;
  if (t < T0_WOUT) { transpose_tile(P.w_out, 2048, 2048, P.wt_out, t % 32, t / 32, false, smem); return; }
  t -= T0_WOUT;
  if (t < T0_ROT) {
    int e = t * 256 + tid;
    int tok = e / 24, i = e % 24;
    float a;
    if (i < 16) { a = (-13.122363377404328f) * (float)i; a = a * (2.0f / 32.0f); }
    else        { a = (-13.122363377404328f) * (float)(i - 16); a = a * (2.0f / 16.0f); }
    float inv = expf(a);
    float ang = (float)P.pos[tok] * inv;
    double rev = (double)ang * 0.15915494309189535;
    rev = rev - rint(rev);
    float fr = (float)rev;
    float s = __builtin_amdgcn_sinf(fr);
    float c = __builtin_amdgcn_cosf(fr);
    if (i < 16) { P.cos128[tok * 16 + i] = c; P.sin128[tok * 16 + i] = s; }
    else        { P.cos64[tok * 8 + i - 16] = c; P.sin64[tok * 8 + i - 16] = s; }
    return;
  }
  t -= T0_ROT;
  {
    int gp = t * 256 + tid;
    int g = gp >> 6, p = gp & 63;
    float dt = expf(P.log_dt[g]);
    float ar = P.a_re[gp], ai = P.a_im[gp];
    float mag = expf(ar * dt);
    float ang = ai * dt;
    double rev = (double)ang * 0.15915494309189535;
    rev = rev - rint(rev);
    float fr = (float)rev;
    float lr = mag * __builtin_amdgcn_cosf(fr);
    float li = mag * __builtin_amdgcn_sinf(fr);
    float den = ar * ar + ai * ai;
    float cr = ((lr - 1.0f) * ar + li * ai) / den;
    float ci = (li * ar - (lr - 1.0f) * ai) / den;
    P.lam[gp * 2] = lr; P.lam[gp * 2 + 1] = li;
    for (int c = 0; c < 16; ++c) {
      float br = P.b_re[gp * 16 + c], bi = P.b_im[gp * 16 + c];
      P.bb[gp * 32 + c] = cr * br - ci * bi;
      P.bb[gp * 32 + 16 + c] = cr * bi + ci * br;
      P.cmT[(g * 16 + c) * 128 + p] = (half_t)P.c_re[(g * 16 + c) * 64 + p];
      P.cmT[(g * 16 + c) * 128 + 64 + p] = (half_t)(-P.c_im[(g * 16 + c) * 64 + p]);
    }
  }
}

constexpr int LDS_ROW = 144;
constexpr int LDS_TILE = 128 * LDS_ROW;
constexpr int LDS_STAGE = 2 * LDS_TILE;

__device__ __forceinline__ void gemm_loop(const half_t* __restrict__ A, int lda, const half_t* __restrict__ B,
                                          int ldb, int K, int m0, int n0, f32x16 (&acc)[2][2], char* smem) {
  const int tid = threadIdx.x, lane = tid & 63, wave = tid >> 6;
  const int wm = wave >> 1, wn = wave & 1;
  const int lrow = tid >> 3, lkc = tid & 7;
  const half_t* ga = A + (size_t)(m0 + lrow) * lda + lkc * 8;
  const half_t* gb = B + (size_t)(n0 + lrow) * ldb + lkc * 8;
  u32x4 ra[4], rb[4];
  const int KT = K >> 6;
#pragma unroll
  for (int i = 0; i < 4; ++i) {
    ra[i] = *(const u32x4*)(ga + (size_t)(32 * i) * lda);
    rb[i] = *(const u32x4*)(gb + (size_t)(32 * i) * ldb);
  }
  __syncthreads();
#pragma unroll
  for (int i = 0; i < 4; ++i) {
    *(u32x4*)(smem + (lrow + 32 * i) * LDS_ROW + lkc * 16) = ra[i];
    *(u32x4*)(smem + LDS_TILE + (lrow + 32 * i) * LDS_ROW + lkc * 16) = rb[i];
  }
  __syncthreads();
  const int arow = (wm * 64 + (lane & 31)) * LDS_ROW + (lane >> 5) * 16;
  const int brow = LDS_TILE + (wn * 64 + (lane & 31)) * LDS_ROW + (lane >> 5) * 16;
  for (int kt = 0; kt < KT; ++kt) {
    const int cur = (kt & 1) * LDS_STAGE;
    const bool nxt = (kt + 1 < KT);
    if (nxt) {
#pragma unroll
      for (int i = 0; i < 4; ++i) {
        ra[i] = *(const u32x4*)(ga + (size_t)(32 * i) * lda + (kt + 1) * 64);
        rb[i] = *(const u32x4*)(gb + (size_t)(32 * i) * ldb + (kt + 1) * 64);
      }
    }
#pragma unroll
    for (int ks = 0; ks < 4; ++ks) {
      half8 a0 = *(const half8*)(smem + cur + arow + ks * 32);
      half8 a1 = *(const half8*)(smem + cur + arow + 32 * LDS_ROW + ks * 32);
      half8 b0 = *(const half8*)(smem + cur + brow + ks * 32);
      half8 b1 = *(const half8*)(smem + cur + brow + 32 * LDS_ROW + ks * 32);
      acc[0][0] = __builtin_amdgcn_mfma_f32_32x32x16_f16(a0, b0, acc[0][0], 0, 0, 0);
      acc[0][1] = __builtin_amdgcn_mfma_f32_32x32x16_f16(a0, b1, acc[0][1], 0, 0, 0);
      acc[1][0] = __builtin_amdgcn_mfma_f32_32x32x16_f16(a1, b0, acc[1][0], 0, 0, 0);
      acc[1][1] = __builtin_amdgcn_mfma_f32_32x32x16_f16(a1, b1, acc[1][1], 0, 0, 0);
    }
    if (nxt) {
      const int nx = ((kt + 1) & 1) * LDS_STAGE;
#pragma unroll
      for (int i = 0; i < 4; ++i) {
        *(u32x4*)(smem + nx + (lrow + 32 * i) * LDS_ROW + lkc * 16) = ra[i];
        *(u32x4*)(smem + nx + LDS_TILE + (lrow + 32 * i) * LDS_ROW + lkc * 16) = rb[i];
      }
    }
    __syncthreads();
  }
}

#define ACC_ROW(mt, i) (wm * 64 + (mt) * 32 + ((i) & 3) + 8 * ((i) >> 2) + 4 * (lane >> 5))
#define ACC_COL(nt) (wn * 64 + (nt) * 32 + (lane & 31))

constexpr int CS_STRIDE = 136;

__device__ __forceinline__ void tile_coords(int t, int NT, int& mt, int& nt) {
  int per = 16 * NT;
  int grp = t / per, r = t - grp * per;
  nt = r >> 4; mt = grp * 16 + (r & 15);
}

__device__ __forceinline__ void g1_tile(const Params& P, int t, char* smem) {
  const int tid = threadIdx.x, lane = tid & 63, wave = tid >> 6;
  const int wm = wave >> 1, wn = wave & 1;
  int mt, nt; tile_coords(t, NP / 128, mt, nt);
  const int m0 = mt * 128, n0 = nt * 128;
  f32x16 acc[2][2];
#pragma unroll
  for (int a = 0; a < 2; ++a)
#pragma unroll
    for (int b = 0; b < 2; ++b)
#pragma unroll
      for (int i = 0; i < 16; ++i) acc[a][b][i] = 0.f;
  gemm_loop(P.h, D, P.wt_in, D, D, m0, n0, acc, smem);
  half_t* cs = (half_t*)smem;
#pragma unroll
  for (int a = 0; a < 2; ++a)
#pragma unroll
    for (int b = 0; b < 2; ++b) {
      const int col = ACC_COL(b);
      const float sc = (n0 + col >= C_WI) ? (1.0f / 32.0f) : 1.0f;
#pragma unroll
      for (int i = 0; i < 16; ++i) cs[ACC_ROW(a, i) * CS_STRIDE + col] = (half_t)(acc[a][b][i] * sc);
    }
  __syncthreads();
#pragma unroll 2
  for (int i = 0; i < 8; ++i) {
    int c = tid + 256 * i;
    int row = c >> 4, cc = (c & 15) * 8;
    int n = n0 + cc, m = m0 + row;
    half8 v = *(const half8*)(cs + row * CS_STRIDE + cc);
    if (n < C_V) {
      int d = n & 127;
      if (d < 32) {
        const bool lo = d < 16;
        half8 o = *(const half8*)(cs + row * CS_STRIDE + (lo ? cc + 16 : cc - 16));
        const int fi = lo ? d : d - 16;
        const float* cp = P.cos128 + (size_t)m * 16 + fi;
        const float* sp = P.sin128 + (size_t)m * 16 + fi;
        half8 r;
#pragma unroll
        for (int j = 0; j < 8; ++j) {
          float cv = cp[j], sv = sp[j];
          float x1 = lo ? (float)v[j] : (float)o[j];
          float x2 = lo ? (float)o[j] : (float)v[j];
          r[j] = (half_t)(lo ? (x1 * cv - x2 * sv) : (x2 * cv + x1 * sv));
        }
        v = r;
      }
    } else if (n >= C_QI && n < C_U) {
      int d = n & 63;
      if (d < 16) {
        const bool lo = d < 8;
        half8 o = *(const half8*)(cs + row * CS_STRIDE + (lo ? cc + 8 : cc - 8));
        const float* cp = P.cos64 + (size_t)m * 8;
        const float* sp = P.sin64 + (size_t)m * 8;
        half8 r;
#pragma unroll
        for (int j = 0; j < 8; ++j) {
          float cv = cp[j], sv = sp[j];
          float x1 = lo ? (float)v[j] : (float)o[j];
          float x2 = lo ? (float)o[j] : (float)v[j];
          r[j] = (half_t)(lo ? (x1 * cv - x2 * sv) : (x2 * cv + x1 * sv));
        }
        v = r;
      }
    }
    if (n >= C_KI && n < C_U) *(half8*)(P.kidx + (size_t)m * 64 + (n - C_KI)) = v;
    else *(half8*)(P.proj + (size_t)m * NP + n) = v;
  }
}

__device__ __forceinline__ void g3_tile(const Params& P, int t, char* smem) {
  const int tid = threadIdx.x, lane = tid & 63, wave = tid >> 6;
  const int wm = wave >> 1, wn = wave & 1;
  int mt, nt; tile_coords(t, 4, mt, nt);
  const int m0 = mt * 128, n0 = nt * 128;
  f32x16 acc[2][2];
#pragma unroll
  for (int a = 0; a < 2; ++a)
#pragma unroll
    for (int b = 0; b < 2; ++b)
#pragma unroll
      for (int i = 0; i < 16; ++i) acc[a][b][i] = 0.f;
  gemm_loop(P.s1, 512, P.wt_glu, 512, 512, m0, n0, acc, smem);
  half_t* cs = (half_t*)smem;
#pragma unroll
  for (int a = 0; a < 2; ++a)
#pragma unroll
    for (int b = 0; b < 2; ++b) {
      const int col = ACC_COL(b);
      const int n = n0 + col;
      const float bg = P.b_glu[n];
#pragma unroll
      for (int i = 0; i < 16; ++i) {
        const int row = ACC_ROW(a, i);
        const size_t m = m0 + row;
        float s1v = (float)P.s1[m * 512 + n];
        float gate = (float)P.proj[m * NP + C_SG + n];
        float v = s1v * sigmoidf_(acc[a][b][i] + bg) * siluf_(gate);
        cs[row * CS_STRIDE + col] = (half_t)v;
      }
    }
  __syncthreads();
#pragma unroll 2
  for (int i = 0; i < 8; ++i) {
    int c = tid + 256 * i;
    int row = c >> 4, cc = (c & 15) * 8;
    *(half8*)(P.sg + (size_t)(m0 + row) * 512 + n0 + cc) = *(const half8*)(cs + row * CS_STRIDE + cc);
  }
}

__device__ __forceinline__ void g24_tile(const Params& P, int t, char* smem) {
  const int tid = threadIdx.x, lane = tid & 63, wave = tid >> 6;
  const int wm = wave >> 1, wn = wave & 1;
  int mt, nt; tile_coords(t, 16, mt, nt);
  const int m0 = mt * 128, n0 = nt * 128;
  f32x16 acc[2][2];
#pragma unroll
  for (int a = 0; a < 2; ++a)
#pragma unroll
    for (int b = 0; b < 2; ++b)
#pragma unroll
      for (int i = 0; i < 16; ++i) acc[a][b][i] = 0.f;
  gemm_loop(P.attg, 1024, P.wt_att, 1024, 1024, m0, n0, acc, smem);
#pragma unroll
  for (int a = 0; a < 2; ++a)
#pragma unroll
    for (int b = 0; b < 2; ++b) {
      const int n = n0 + ACC_COL(b);
      const float b0 = P.b_merge[n], b1 = P.b_merge[2048 + n];
#pragma unroll
      for (int i = 0; i < 16; ++i) {
        const size_t m = m0 + ACC_ROW(a, i);
        float e0 = __expf(-((float)P.proj[m * NP + C_MG + n] + b0));
        float e1 = __expf(-((float)P.proj[m * NP + C_MG + 2048 + n] + b1));
        acc[a][b][i] *= (1.0f + e1) / (1.0f + e0);
      }
    }
  gemm_loop(P.sg, 512, P.wt_ssm, 512, 512, m0, n0, acc, smem);
  half_t* cs = (half_t*)smem;
#pragma unroll
  for (int a = 0; a < 2; ++a)
#pragma unroll
    for (int b = 0; b < 2; ++b) {
      const int col = ACC_COL(b);
      const int n = n0 + col;
      const float b1 = P.b_merge[2048 + n];
#pragma unroll
      for (int i = 0; i < 16; ++i) {
        const int row = ACC_ROW(a, i);
        const size_t m = m0 + row;
        float g1 = sigmoidf_((float)P.proj[m * NP + C_MG + 2048 + n] + b1);
        cs[row * CS_STRIDE + col] = (half_t)(acc[a][b][i] * g1);
      }
    }
  __syncthreads();
  half_t* mixed = P.h;
#pragma unroll 2
  for (int i = 0; i < 8; ++i) {
    int c = tid + 256 * i;
    int row = c >> 4, cc = (c & 15) * 8;
    *(half8*)(mixed + (size_t)(m0 + row) * D + n0 + cc) = *(const half8*)(cs + row * CS_STRIDE + cc);
  }
}

__device__ __forceinline__ void g5_tile(const Params& P, int t, char* smem) {
  const int tid = threadIdx.x, lane = tid & 63, wave = tid >> 6;
  const int wm = wave >> 1, wn = wave & 1;
  int mt, nt; tile_coords(t, 16, mt, nt);
  const int m0 = mt * 128, n0 = nt * 128;
  f32x16 acc[2][2];
#pragma unroll
  for (int a = 0; a < 2; ++a)
#pragma unroll
    for (int b = 0; b < 2; ++b)
#pragma unroll
      for (int i = 0; i < 16; ++i) acc[a][b][i] = 0.f;
  gemm_loop(P.h, D, P.wt_out, D, D, m0, n0, acc, smem);
#pragma unroll
  for (int a = 0; a < 2; ++a)
#pragma unroll
    for (int b = 0; b < 2; ++b) {
      const int n = n0 + ACC_COL(b);
#pragma unroll
      for (int i = 0; i < 16; ++i) {
        const size_t m = m0 + ACC_ROW(a, i);
        P.out[m * D + n] = P.x[m * D + n] + acc[a][b][i];
      }
    }
}

__device__ __forceinline__ void fn_task(const Params& P, int t) {
  const int tid = threadIdx.x, lane = tid & 63, wave = tid >> 6;
  int row = t * 4 + wave;
  float4* xr = (float4*)(P.out + (size_t)row * D);
  float4 v[8]; float ss = 0.f;
#pragma unroll
  for (int j = 0; j < 8; ++j) { v[j] = xr[j * 64 + lane]; ss += v[j].x * v[j].x + v[j].y * v[j].y + v[j].z * v[j].z + v[j].w * v[j].w; }
  ss = wave_sum(ss);
  float sc = rsqrtf(ss * (1.0f / D) + 1e-6f);
  const float4* g4 = (const float4*)P.g_final;
#pragma unroll
  for (int j = 0; j < 8; ++j) {
    float4 g = g4[j * 64 + lane];
    float4 o; o.x = v[j].x * sc * g.x; o.y = v[j].y * sc * g.y; o.z = v[j].z * sc * g.z; o.w = v[j].w * sc * g.w;
    xr[j * 64 + lane] = o;
  }
}

__device__ __forceinline__ void ssm_local(const Params& P, int item, char* smem, bool final_pass) {
  const int tid = threadIdx.x, lane = tid & 63, wave = tid >> 6;
  const int it = item * 4 + wave;
  const int n = it >> 5, g = it & 31;
  half_t* ub = (half_t*)(smem + wave * 2048);
  half_t* xs = (half_t*)(smem + 8192 + wave * 16384);
  __syncthreads();
  {
    const u32x4* src = (const u32x4*)(P.proj + (size_t)(n * 64 + lane) * NP + C_U + g * 16);
    u32x4 u0 = src[0], u1 = src[1];
    *(u32x4*)(ub + lane * 16) = u0;
    *(u32x4*)(ub + lane * 16 + 8) = u1;
  }
  const int gp = g * 64 + lane;
  float bre[16], bim[16];
  {
    const float4* b4 = (const float4*)(P.bb + (size_t)gp * 32);
#pragma unroll
    for (int j = 0; j < 4; ++j) { float4 v = b4[j]; bre[4 * j] = v.x; bre[4 * j + 1] = v.y; bre[4 * j + 2] = v.z; bre[4 * j + 3] = v.w; }
#pragma unroll
    for (int j = 0; j < 4; ++j) { float4 v = b4[4 + j]; bim[4 * j] = v.x; bim[4 * j + 1] = v.y; bim[4 * j + 2] = v.z; bim[4 * j + 3] = v.w; }
  }
  const float lr = P.lam[gp * 2], li = P.lam[gp * 2 + 1];
  float xr = 0.f, xi = 0.f;
  if (final_pass) { xr = P.E[((size_t)n * 2048 + gp) * 2]; xi = P.E[((size_t)n * 2048 + gp) * 2 + 1]; }
  __syncthreads();
#pragma unroll 4
  for (int tk = 0; tk < 64; ++tk) {
    half8 ua = *(const half8*)(ub + tk * 16);
    half8 uc = *(const half8*)(ub + tk * 16 + 8);
    float br = 0.f, bi = 0.f;
#pragma unroll
    for (int c = 0; c < 8; ++c) { float uv = (float)ua[c]; br += bre[c] * uv; bi += bim[c] * uv; }
#pragma unroll
    for (int c = 0; c < 8; ++c) { float uv = (float)uc[c]; br += bre[8 + c] * uv; bi += bim[8 + c] * uv; }
    float nr = lr * xr - li * xi + br;
    float ni = lr * xi + li * xr + bi;
    xr = nr; xi = ni;
    if (final_pass) {
      xs[tk * 128 + lane] = (half_t)xr;
      xs[tk * 128 + 64 + lane] = (half_t)xi;
    }
  }
  if (!final_pass) {
    P.E[((size_t)n * 2048 + gp) * 2] = xr;
    P.E[((size_t)n * 2048 + gp) * 2 + 1] = xi;
    return;
  }
  half8 bf[4];
#pragma unroll
  for (int ks = 0; ks < 4; ++ks)
    bf[ks] = *(const half8*)(P.cmT + (size_t)(g * 16 + (lane & 15)) * 128 + ks * 32 + (lane >> 4) * 8);
  const float dsk = P.ssm_d[g * 16 + (lane & 15)];
#pragma unroll
  for (int rt = 0; rt < 4; ++rt) {
    f32x4 y = {0.f, 0.f, 0.f, 0.f};
#pragma unroll
    for (int ks = 0; ks < 4; ++ks) {
      half8 af = *(const half8*)(xs + (rt * 16 + (lane & 15)) * 128 + ks * 32 + (lane >> 4) * 8);
      y = __builtin_amdgcn_mfma_f32_16x16x32_f16(af, bf[ks], y, 0, 0, 0);
    }
#pragma unroll
    for (int i = 0; i < 4; ++i) {
      int tk = rt * 16 + (lane >> 4) * 4 + i;
      float uv = (float)ub[tk * 16 + (lane & 15)];
      float yv = y[i] + dsk * uv;
      P.s1[(size_t)(n * 64 + tk) * 512 + g * 16 + (lane & 15)] = (half_t)gelu_tanh(yv);
    }
  }
}

__device__ __forceinline__ void ssm_carry(const Params& P, int blk) {
  const int gp = blk * 256 + threadIdx.x;
  float lr = P.lam[gp * 2], li = P.lam[gp * 2 + 1];
#pragma unroll
  for (int s = 0; s < 6; ++s) { float nr = lr * lr - li * li; float ni = 2.0f * lr * li; lr = nr; li = ni; }
  float sr = 0.f, si = 0.f;
  float2* Ep = (float2*)P.E;
#pragma unroll 8
  for (int n = 0; n < 256; ++n) {
    float2 e = Ep[(size_t)n * 2048 + gp];
    Ep[(size_t)n * 2048 + gp] = make_float2(sr, si);
    float nr = lr * sr - li * si + e.x;
    float ni = lr * si + li * sr + e.y;
    sr = nr; si = ni;
  }
}

constexpr int QROW = 2064;

__device__ __forceinline__ void idx_score_item(const Params& P, int band, int item, char* smem) {
  const int tid = threadIdx.x, lane = tid & 63, wave = tid >> 6;
  const int qt = item & 63, piece = item >> 6;
  const int q0 = band * BAND + qt * 32;
  const int nadm = 64 * ((q0 >> 6) + 1);
  const int k0 = piece * KP;
  if (k0 >= nadm) return;
  const int kend = min(k0 + KP, nadm);
  __syncthreads();
#pragma unroll 4
  for (int i = 0; i < 16; ++i) {
    int c = tid + 256 * i;
    int r = c >> 7, cc = c & 127;
    u32x4 v = *(const u32x4*)(P.proj + (size_t)(q0 + r) * NP + C_QI + cc * 8);
    *(u32x4*)(smem + r * QROW + cc * 16) = v;
  }
  float* wl = (float*)(smem + 32 * QROW);
  if (tid < 64) {
    const half8 wv = *(const half8*)(P.proj + (size_t)(q0 + (tid & 31)) * NP + C_WI + (tid >> 5) * 8);
#pragma unroll
    for (int j = 0; j < 8; ++j) wl[((tid >> 5) * 8 + j) * 32 + (tid & 31)] = (float)wv[j];
  }
  __syncthreads();
  float* S = P.out;
  const char* qbase = smem + (lane & 31) * QROW + (lane >> 5) * 16;
  for (int slab = k0 + wave * 64; slab < kend; slab += 256) {
    half8 kf[2][4];
#pragma unroll
    for (int st = 0; st < 2; ++st)
#pragma unroll
      for (int ks = 0; ks < 4; ++ks)
        kf[st][ks] = *(const half8*)(P.kidx + (size_t)(slab + st * 32 + (lane & 31)) * 64 + ks * 16 + (lane >> 5) * 8);
    f32x16 acc[2];
#pragma unroll
    for (int i = 0; i < 16; ++i) { acc[0][i] = 0.f; acc[1][i] = 0.f; }
#pragma unroll 2
    for (int h = 0; h < 16; ++h) {
      const float wh = wl[h * 32 + (lane & 31)];
      half8 qf[4];
#pragma unroll
      for (int ks = 0; ks < 4; ++ks) qf[ks] = *(const half8*)(qbase + h * 128 + ks * 32);
#pragma unroll
      for (int st = 0; st < 2; ++st) {
        f32x16 lg;
#pragma unroll
        for (int i = 0; i < 16; ++i) lg[i] = 0.f;
#pragma unroll
        for (int ks = 0; ks < 4; ++ks) lg = __builtin_amdgcn_mfma_f32_32x32x16_f16(kf[st][ks], qf[ks], lg, 0, 0, 0);
#pragma unroll
        for (int i = 0; i < 16; ++i) acc[st][i] += fmaxf(lg[i], 0.f) * wh;
      }
    }
    float* srow = S + (size_t)(qt * 32 + (lane & 31)) * L + slab + 4 * (lane >> 5);
#pragma unroll
    for (int st = 0; st < 2; ++st)
#pragma unroll
      for (int g = 0; g < 4; ++g) {
        float4 v = make_float4(acc[st][4 * g], acc[st][4 * g + 1], acc[st][4 * g + 2], acc[st][4 * g + 3]);
        *(float4*)(srow + st * 32 + 8 * g) = v;
      }
  }
}

__device__ __forceinline__ unsigned mono_key(float f) {
  unsigned u = __float_as_uint(f);
  return (u & 0x80000000u) ? ~u : (u | 0x80000000u);
}

__device__ __forceinline__ void idx_select_row(const Params& P, int band, int r, char* smem) {
  const int tid = threadIdx.x, lane = tid & 63, wave = tid >> 6;
  const int q = band * BAND + r;
  const int n = 64 * ((q >> 6) + 1);
  unsigned short* selq = P.sel + (size_t)q * 256;
  if (n <= 256) {
    selq[tid] = (unsigned short)(tid < n ? tid : 0);
    return;
  }
  int* red = (int*)smem;
  const float* S = P.out + (size_t)r * L;
  const int nper = n >> 8;
  const int nfull = (n + 255) >> 8;
  unsigned v[64];
#pragma unroll
  for (int j = 0; j < 64; ++j) {
    v[j] = 0u;
    if (j < nfull) { int idx = j * 256 + tid; if (idx < n) v[j] = mono_key(S[idx]); }
  }
  (void)nper;
  __syncthreads();
  unsigned T = 0u; bool exact = false; unsigned thr = 0u;
  for (int bit = 31; bit >= 0; --bit) {
    const unsigned cand = T | (1u << bit);
    int cnt = 0;
#pragma unroll
    for (int j = 0; j < 64; ++j)
      if (j < nfull) cnt += __popcll(__ballot(v[j] >= cand));
    int* slot = red + ((bit & 1) << 2);
    if (lane == 0) slot[wave] = cnt;
    __syncthreads();
    const int total = slot[0] + slot[1] + slot[2] + slot[3];
    if (total >= 256) { T = cand; if (total == 256) { exact = true; thr = cand; break; } }
  }
  int need_eq = 0;
  if (!exact) {
    thr = T + 1u;
  }
  int wc = 0;
#pragma unroll
  for (int j = 0; j < 64; ++j)
    if (j < nfull) wc += __popcll(__ballot(v[j] >= thr));
  int* pre = red + 8;
  __syncthreads();
  if (lane == 0) pre[wave] = wc;
  __syncthreads();
  int base = 0, tot = 0;
#pragma unroll
  for (int w2 = 0; w2 < 4; ++w2) { int c = pre[w2]; if (w2 < wave) base += c; tot += c; }
  const unsigned long long lt = (lane == 0) ? 0ull : (~0ull >> (64 - lane));
#pragma unroll
  for (int j = 0; j < 64; ++j)
    if (j < nfull) {
      const bool s = v[j] >= thr;
      const unsigned long long m = __ballot(s);
      if (s) selq[base + __popcll(m & lt)] = (unsigned short)(j * 256 + tid);
      base += __popcll(m);
    }
  if (!exact) {
    need_eq = 256 - tot;
    if (wave == 0) {
      int filled = 0;
      for (int i0 = 0; i0 < n && filled < need_eq; i0 += 64) {
        const unsigned key = mono_key(S[i0 + lane]);
        const bool e = (key == T);
        const unsigned long long m = __ballot(e);
        const int pos = filled + __popcll(m & lt);
        if (e && pos < need_eq) selq[tot + pos] = (unsigned short)(i0 + lane);
        filled += __popcll(m);
      }
    }
  }
}

__device__ __forceinline__ void attn_item(const Params& P, int item, char* smem) {
  const int tid = threadIdx.x, lane = tid & 63, wave = tid >> 6;
  const int gw = item * 4 + wave;
  const int q = gw >> 1, kvh = gw & 1;
  const int nsel = min(256, 64 * ((q >> 6) + 1));
  char* wsm = smem + wave * 6144;
  unsigned short* sidx = (unsigned short*)wsm;
  float* pbuf = (float*)(wsm + 512);
  float* psum = (float*)(wsm + 512 + 4096);
  __syncthreads();
  *(uint2*)(sidx + lane * 4) = *(const uint2*)(P.sel + (size_t)q * 256 + lane * 4);
  const int hn = lane & 15, kg = lane >> 4;
  half8 qf[4];
#pragma unroll
  for (int ks = 0; ks < 4; ++ks) {
    half8 z;
#pragma unroll
    for (int j = 0; j < 8; ++j) z[j] = (half_t)0.f;
    if (hn < 4) z = *(const half8*)(P.proj + (size_t)q * NP + C_Q + (kvh * 4 + hn) * 128 + ks * 32 + kg * 8);
    qf[ks] = z;
  }
  __syncthreads();
  f32x4 st[16];
#pragma unroll
  for (int t = 0; t < 16; ++t) {
    const int idx = sidx[t * 16 + hn];
    const half_t* kp = P.proj + (size_t)idx * NP + C_K + kvh * 128 + kg * 8;
    f32x4 s = {0.f, 0.f, 0.f, 0.f};
#pragma unroll
    for (int ks = 0; ks < 4; ++ks) {
      half8 kf = *(const half8*)(kp + ks * 32);
      s = __builtin_amdgcn_mfma_f32_16x16x32_f16(kf, qf[ks], s, 0, 0, 0);
    }
    st[t] = s;
  }
  const float scale = 0.08838834764831845f;
  float mx = -INFINITY;
#pragma unroll
  for (int t = 0; t < 16; ++t)
#pragma unroll
    for (int i = 0; i < 4; ++i) {
      const int slot = t * 16 + kg * 4 + i;
      float s = (slot < nsel) ? st[t][i] * scale : -INFINITY;
      st[t][i] = s;
      mx = fmaxf(mx, s);
    }
  mx = fmaxf(mx, __shfl_xor(mx, 16, 64));
  mx = fmaxf(mx, __shfl_xor(mx, 32, 64));
  float sum = 0.f;
#pragma unroll
  for (int t = 0; t < 16; ++t)
#pragma unroll
    for (int i = 0; i < 4; ++i) {
      float p = __expf(st[t][i] - mx);
      sum += p;
      if (hn < 4) pbuf[(t * 16 + kg * 4 + i) * 4 + hn] = p;
    }
  sum += __shfl_xor(sum, 16, 64);
  sum += __shfl_xor(sum, 32, 64);
  if (lane < 4) psum[lane] = sum;
  __syncthreads();
  float o[4][2];
#pragma unroll
  for (int h = 0; h < 4; ++h) { o[h][0] = 0.f; o[h][1] = 0.f; }
  const half_t* vbase = P.proj + C_V + kvh * 128 + lane * 2;
#pragma unroll 8
  for (int s = 0; s < nsel; ++s) {
    const int idx = sidx[s];
    const half2v vv = *(const half2v*)(vbase + (size_t)idx * NP);
    const float4 p4 = *(const float4*)(pbuf + s * 4);
    const float v0 = (float)vv.x, v1 = (float)vv.y;
    o[0][0] += p4.x * v0; o[0][1] += p4.x * v1;
    o[1][0] += p4.y * v0; o[1][1] += p4.y * v1;
    o[2][0] += p4.z * v0; o[2][1] += p4.z * v1;
    o[3][0] += p4.w * v0; o[3][1] += p4.w * v1;
  }
#pragma unroll
  for (int h = 0; h < 4; ++h) {
    const float inv = 1.0f / psum[h];
    const int col = (kvh * 4 + h) * 128 + lane * 2;
    const half2v gt = *(const half2v*)(P.proj + (size_t)q * NP + C_AG + col);
    half2v r;
    r.x = (half_t)(o[h][0] * inv * siluf_((float)gt.x));
    r.y = (half_t)(o[h][1] * inv * siluf_((float)gt.y));
    *(half2v*)(P.attg + (size_t)q * 1024 + col) = r;
  }
}

__device__ __forceinline__ void run_phase(const Params& P, int ph, char* smem) {
  const int nb = gridDim.x, bid = blockIdx.x;
  if (ph == 0) { for (int t = bid; t < T0_TOTAL; t += nb) prep_task(P, t, smem); }
  else if (ph == 1) { for (int t = bid; t < 128 * (NP / 128); t += nb) g1_tile(P, t, smem); }
  else if (ph == 2) { for (int t = bid; t < 2048; t += nb) ssm_local(P, t, smem, false); }
  else if (ph == 3) { if (bid < 8) ssm_carry(P, bid); }
  else if (ph == 4) { for (int t = bid; t < 2048; t += nb) ssm_local(P, t, smem, true); }
  else if (ph == 5) { for (int t = bid; t < 128 * 4; t += nb) g3_tile(P, t, smem); }
  else if (ph < 22) {
    const int b = (ph - 6) >> 1;
    if (((ph - 6) & 1) == 0) {
      const int nitems = 64 * ((BAND * (b + 1)) / KP);
      for (int t = bid; t < nitems; t += nb) idx_score_item(P, b, t, smem);
    } else {
      for (int t = bid; t < BAND; t += nb) { __syncthreads(); idx_select_row(P, b, t, smem); }
    }
  }
  else if (ph == 22) { for (int t = bid; t < L * 2 / 4; t += nb) attn_item(P, t, smem); }
  else if (ph == 23) { for (int t = bid; t < 128 * 16; t += nb) g24_tile(P, t, smem); }
  else if (ph == 24) { for (int t = bid; t < 128 * 16; t += nb) g5_tile(P, t, smem); }
  else if (ph == 25) { for (int t = bid; t < L / 4; t += nb) fn_task(P, t); }
}

template <int PH>
__global__ void __launch_bounds__(256, 2) k_ph(Params P) {
  __shared__ __attribute__((aligned(16))) char smem[SMEM_BYTES];
  run_phase(P, PH, smem);
}
__global__ void __launch_bounds__(256, 2) k_score(Params P, int b) {
  __shared__ __attribute__((aligned(16))) char smem[SMEM_BYTES];
  const int nb = gridDim.x, bid = blockIdx.x;
  const int nitems = 64 * ((BAND * (b + 1)) / KP);
  for (int t = bid; t < nitems; t += nb) idx_score_item(P, b, t, smem);
}
__global__ void __launch_bounds__(256, 2) k_select(Params P, int b) {
  __shared__ __attribute__((aligned(16))) char smem[SMEM_BYTES];
  const int nb = gridDim.x, bid = blockIdx.x;
  for (int t = bid; t < BAND; t += nb) { __syncthreads(); idx_select_row(P, b, t, smem); }
}

#if MEGA
__global__ void __launch_bounds__(256, 2) k_mega(Params P) {
  __shared__ __attribute__((aligned(16))) char smem[SMEM_BYTES];
  cg::grid_group grid = cg::this_grid();
  const int nb = gridDim.x, bid = blockIdx.x;
  run_phase(P, 0, smem); grid.sync();
  run_phase(P, 1, smem); grid.sync();
  run_phase(P, 2, smem); grid.sync();
  run_phase(P, 3, smem); grid.sync();
  run_phase(P, 4, smem); grid.sync();
  run_phase(P, 5, smem); grid.sync();
  for (int b = 0; b < 8; ++b) {
    const int nitems = 64 * ((BAND * (b + 1)) / KP);
    for (int t = bid; t < nitems; t += nb) idx_score_item(P, b, t, smem);
    grid.sync();
    for (int t = bid; t < BAND; t += nb) { __syncthreads(); idx_select_row(P, b, t, smem); }
    grid.sync();
  }
  run_phase(P, 22, smem); grid.sync();
  run_phase(P, 23, smem); grid.sync();
  run_phase(P, 24, smem); grid.sync();
  run_phase(P, 25, smem);
}
#endif

extern "C" void kernel_launch(void* const* d_in, const int* in_sizes, int n_in, void* d_out, int out_size,
                              void* d_ws, size_t ws_size, hipStream_t stream) {
  Params p{};
  p.x = (const float*)d_in[0]; p.pos = (const int*)d_in[1]; p.g_norm = (const float*)d_in[2];
  p.w_in = (const float*)d_in[3]; p.b_merge = (const float*)d_in[4]; p.a_re = (const float*)d_in[5];
  p.a_im = (const float*)d_in[6]; p.log_dt = (const float*)d_in[7]; p.b_re = (const float*)d_in[8];
  p.b_im = (const float*)d_in[9]; p.c_re = (const float*)d_in[10]; p.c_im = (const float*)d_in[11];
  p.ssm_d = (const float*)d_in[12]; p.w_glu = (const float*)d_in[13]; p.b_glu = (const float*)d_in[14];
  p.w_att_out = (const float*)d_in[15]; p.w_ssm_out = (const float*)d_in[16]; p.w_out = (const float*)d_in[17];
  p.g_final = (const float*)d_in[18];
  p.out = (float*)d_out;
  char* ws = (char*)d_ws;
  size_t off = 0;
  auto take = [&](size_t bytes) { char* r = ws + off; off += (bytes + 255) & ~(size_t)255; return r; };
  p.proj = (half_t*)take((size_t)L * NP * 2);
  p.kidx = (half_t*)take((size_t)L * 64 * 2);
  p.h = (half_t*)take((size_t)L * D * 2);
  p.wt_in = (half_t*)take((size_t)NP * D * 2);
  p.wt_att = (half_t*)take((size_t)2048 * 1024 * 2);
  p.wt_glu = (half_t*)take((size_t)512 * 512 * 2);
  p.wt_ssm = (half_t*)take((size_t)2048 * 512 * 2);
  p.wt_out = (half_t*)take((size_t)2048 * 2048 * 2);
  p.s1 = (half_t*)take((size_t)L * 512 * 2);
  p.sg = (half_t*)take((size_t)L * 512 * 2);
  p.attg = (half_t*)take((size_t)L * 1024 * 2);
  p.cmT = (half_t*)take((size_t)32 * 16 * 128 * 2);
  p.cos128 = (float*)take((size_t)L * 16 * 4);
  p.sin128 = (float*)take((size_t)L * 16 * 4);
  p.cos64 = (float*)take((size_t)L * 8 * 4);
  p.sin64 = (float*)take((size_t)L * 8 * 4);
  p.lam = (float*)take((size_t)2048 * 2 * 4);
  p.bb = (float*)take((size_t)2048 * 32 * 4);
  p.E = (float*)take((size_t)256 * 2048 * 2 * 4);
  p.sel = (unsigned short*)take((size_t)L * 256 * 2);
  if (off > ws_size) { fprintf(stderr, "workspace too small: need %zu have %zu\n", off, ws_size); return; }
#if MEGA
  static int grid_blocks = 0;
  if (!grid_blocks) {
    int dev = 0, cus = 0, per_cu = 0;
    hipGetDevice(&dev);
    hipDeviceGetAttribute(&cus, hipDeviceAttributeMultiprocessorCount, dev);
    hipOccupancyMaxActiveBlocksPerMultiprocessor(&per_cu, k_mega, 256, 0);
    if (per_cu > 2) per_cu = 2;
    grid_blocks = cus * per_cu;
  }
  void* args[] = {&p};
  hipError_t e = hipLaunchCooperativeKernel((void*)k_mega, dim3(grid_blocks), dim3(256), args, 0, stream);
  if (e != hipSuccess) fprintf(stderr, "cooperative launch failed: %s (grid %d)\n", hipGetErrorString(e), grid_blocks);
#else
  k_ph<0><<<1024, 256, 0, stream>>>(p);
  k_ph<1><<<512, 256, 0, stream>>>(p);
  k_ph<2><<<512, 256, 0, stream>>>(p);
  k_ph<3><<<8, 256, 0, stream>>>(p);
  k_ph<4><<<512, 256, 0, stream>>>(p);
  k_ph<5><<<512, 256, 0, stream>>>(p);
  for (int b = 0; b < 8; ++b) { k_score<<<512, 256, 0, stream>>>(p, b); k_select<<<1024, 256, 0, stream>>>(p, b); }
  k_ph<22><<<1024, 256, 0, stream>>>(p);
  k_ph<23><<<512, 256, 0, stream>>>(p);
  k_ph<24><<<512, 256, 0, stream>>>(p);
  k_ph<25><<<1024, 256, 0, stream>>>(p);
#endif
}
```

```cpp
#include <hip/hip_runtime.h>
#include <hip/hip_cooperative_groups.h>
#include <stdint.h>
#include <stdio.h>
namespace cg = cooperative_groups;

#ifndef MEGA
#define MEGA 1
#endif
#ifndef REP_G1
#define REP_G1 1
#endif
#ifndef REP_SC
#define REP_SC 1
#endif
#ifndef REP_SEL
#define REP_SEL 1
#endif
#ifndef REP_ATT
#define REP_ATT 1
#endif
#ifndef REP_SSM
#define REP_SSM 1
#endif
#ifndef REP_G24
#define REP_G24 1
#endif
#ifndef REP_P0
#define REP_P0 1
#endif
#ifndef REP_S3
#define REP_S3 1
#endif
#ifndef REP_G3
#define REP_G3 1
#endif
#ifndef REP_G5
#define REP_G5 1
#endif

typedef _Float16 half_t;
typedef _Float16 half8 __attribute__((ext_vector_type(8)));
typedef _Float16 half4 __attribute__((ext_vector_type(4)));
typedef _Float16 half2v __attribute__((ext_vector_type(2)));
typedef float f32x16 __attribute__((ext_vector_type(16)));
typedef float f32x4 __attribute__((ext_vector_type(4)));
typedef unsigned int u32x4 __attribute__((ext_vector_type(4)));

constexpr int L = 16384, D = 2048, NIN = 8784, NP = 8832;
constexpr int C_Q = 0, C_K = 1024, C_V = 1280, C_AG = 1536, C_QI = 2560, C_KI = 3584, C_U = 3648,
              C_SG = 4160, C_MG = 4672, C_WI = 8768;
constexpr int SMEM_BYTES = 53248;
constexpr int BAND = 2048;
constexpr int NBAND = 6;
__device__ __host__ __forceinline__ constexpr int band_q0(int b) { return b < 2 ? 4096 * b : 8192 + 2048 * (b - 2); }
__device__ __host__ __forceinline__ constexpr int band_rows(int b) { return b < 2 ? 4096 : 2048; }
__device__ __host__ __forceinline__ constexpr int band_stride(int b) { return b == 0 ? 4096 : (b == 1 ? 8192 : 16384); }
constexpr int KP = 1024;
constexpr int NPHASE = 26;

constexpr size_t al256(size_t x) { return (x + 255) & ~(size_t)255; }
constexpr size_t OFF_proj = 0;
constexpr size_t OFF_kidx = OFF_proj + al256((size_t)L * NP * 2);
constexpr size_t OFF_h = OFF_kidx + al256((size_t)L * 64 * 2);
constexpr size_t OFF_wt_in = OFF_h + al256((size_t)L * D * 2);
constexpr size_t OFF_wt_att = OFF_wt_in + al256((size_t)NP * D * 2);
constexpr size_t OFF_wt_glu = OFF_wt_att + al256((size_t)2048 * 1024 * 2);
constexpr size_t OFF_wt_ssm = OFF_wt_glu + al256((size_t)512 * 512 * 2);
constexpr size_t OFF_wt_out = OFF_wt_ssm + al256((size_t)2048 * 512 * 2);
constexpr size_t OFF_s1 = OFF_wt_out + al256((size_t)2048 * 2048 * 2);
constexpr size_t OFF_sg = OFF_s1 + al256((size_t)L * 512 * 2);
constexpr size_t OFF_attg = OFF_sg + al256((size_t)L * 512 * 2);
constexpr size_t OFF_cmT = OFF_attg + al256((size_t)L * 1024 * 2);
constexpr size_t OFF_cos128 = OFF_cmT + al256((size_t)32 * 16 * 128 * 2);
constexpr size_t OFF_sin128 = OFF_cos128 + al256((size_t)L * 16 * 4);
constexpr size_t OFF_cos64 = OFF_sin128 + al256((size_t)L * 16 * 4);
constexpr size_t OFF_sin64 = OFF_cos64 + al256((size_t)L * 8 * 4);
constexpr size_t OFF_lam = OFF_sin64 + al256((size_t)L * 8 * 4);
constexpr size_t OFF_bb = OFF_lam + al256((size_t)2048 * 2 * 4);
constexpr size_t OFF_E = OFF_bb + al256((size_t)2048 * 32 * 4);
constexpr size_t OFF_sel = OFF_E + al256((size_t)256 * 2048 * 2 * 4);
constexpr size_t OFF_bar = OFF_sel + al256((size_t)L * 256 * 2);
constexpr size_t WS_NEEDED = OFF_bar + al256((size_t)3456 * 4);
struct Params {
  const float* x; const int* pos; const float* g_norm; const float* w_in; const float* b_merge;
  const float* a_re; const float* a_im; const float* log_dt; const float* b_re; const float* b_im;
  const float* c_re; const float* c_im; const float* ssm_d; const float* w_glu; const float* b_glu;
  const float* w_att_out; const float* w_ssm_out; const float* w_out; const float* g_final;
  float* out;
  char* ws;
  __device__ __host__ __forceinline__ half_t* proj() const { return (half_t*)(ws + OFF_proj); }
  __device__ __host__ __forceinline__ half_t* kidx() const { return (half_t*)(ws + OFF_kidx); }
  __device__ __host__ __forceinline__ half_t* h() const { return (half_t*)(ws + OFF_h); }
  __device__ __host__ __forceinline__ half_t* wt_in() const { return (half_t*)(ws + OFF_wt_in); }
  __device__ __host__ __forceinline__ half_t* wt_att() const { return (half_t*)(ws + OFF_wt_att); }
  __device__ __host__ __forceinline__ half_t* wt_glu() const { return (half_t*)(ws + OFF_wt_glu); }
  __device__ __host__ __forceinline__ half_t* wt_ssm() const { return (half_t*)(ws + OFF_wt_ssm); }
  __device__ __host__ __forceinline__ half_t* wt_out() const { return (half_t*)(ws + OFF_wt_out); }
  __device__ __host__ __forceinline__ half_t* s1() const { return (half_t*)(ws + OFF_s1); }
  __device__ __host__ __forceinline__ half_t* sg() const { return (half_t*)(ws + OFF_sg); }
  __device__ __host__ __forceinline__ half_t* attg() const { return (half_t*)(ws + OFF_attg); }
  __device__ __host__ __forceinline__ half_t* cmT() const { return (half_t*)(ws + OFF_cmT); }
  __device__ __host__ __forceinline__ float* cos128() const { return (float*)(ws + OFF_cos128); }
  __device__ __host__ __forceinline__ float* sin128() const { return (float*)(ws + OFF_sin128); }
  __device__ __host__ __forceinline__ float* cos64() const { return (float*)(ws + OFF_cos64); }
  __device__ __host__ __forceinline__ float* sin64() const { return (float*)(ws + OFF_sin64); }
  __device__ __host__ __forceinline__ float* lam() const { return (float*)(ws + OFF_lam); }
  __device__ __host__ __forceinline__ float* bb() const { return (float*)(ws + OFF_bb); }
  __device__ __host__ __forceinline__ float* E() const { return (float*)(ws + OFF_E); }
  __device__ __host__ __forceinline__ unsigned short* sel() const { return (unsigned short*)(ws + OFF_sel); }
  __device__ __host__ __forceinline__ unsigned* bar() const { return (unsigned*)(ws + OFF_bar); }
};


#define XB_TMO      128
#define XB_XCNT(j)  (256  + 64 * (j))
#define XB_XSUB(j)  (1280 + 64 * (j))
#define XB_XGEN(j)  (2304 + 64 * (j))
#define XB_TOP      3328
#define XB_TOPGEN   3392
#define XCD_BAR_WORDS 3456
#define XB_SPIN_CAP (1u << 18)
#define LAS __attribute__((address_space(3)))

__device__ __forceinline__ unsigned xb_ld(unsigned* p)              { return __hip_atomic_load(p, __ATOMIC_RELAXED, __HIP_MEMORY_SCOPE_AGENT); }
__device__ __forceinline__ unsigned xb_add(unsigned* p, unsigned v) { return __hip_atomic_fetch_add(p, v, __ATOMIC_RELAXED, __HIP_MEMORY_SCOPE_AGENT); }
__device__ __forceinline__ unsigned xb_xcc_id() { return (unsigned)__builtin_amdgcn_s_getreg((3 << 11) | 20) & 0xFu; }
#define XB_SPIN(cond, bar) do { unsigned _sp = 0; while (cond) { __builtin_amdgcn_s_sleep(1); \
    if ((++_sp & 255u) == 0u) { if (xb_ld(&(bar)[XB_TMO])) break; if (_sp > XB_SPIN_CAP) { atomicAdd(&(bar)[XB_TMO], 1u); break; } } } } while (0)

struct XcdBarrier { unsigned* bar; unsigned x; volatile LAS unsigned* st; };

__device__ __forceinline__ XcdBarrier xcd_barrier_post(unsigned* bar, volatile LAS unsigned* st) {
    XcdBarrier b; b.bar = bar; b.x = xb_xcc_id(); b.st = st;
    if (threadIdx.x == 0) (void)xb_add(&bar[XB_XCNT(b.x)], 1u);
    return b;
}
__device__ __forceinline__ void xcd_barrier_complete(unsigned* bar, unsigned x, unsigned& nloc, unsigned& nx) {
    const unsigned G = gridDim.x * gridDim.y * gridDim.z;
    unsigned sum, cnt, mine, sp = 0u;
    for (;;) {
        sum = 0u; cnt = 0u; mine = 0u;
#pragma unroll
        for (unsigned j = 0; j < 16; ++j) { const unsigned c = xb_ld(&bar[XB_XCNT(j)]); sum += c; cnt += (c > 0u) ? 1u : 0u; mine = (j == x) ? c : mine; }
        if (sum == G) break;
        __builtin_amdgcn_s_sleep(1);
        if ((++sp & 255u) == 0u) { if (xb_ld(&bar[XB_TMO])) break; if (sp > XB_SPIN_CAP) { atomicAdd(&bar[XB_TMO], 1u); break; } }
    }
    nloc = mine > 0u ? mine : 1u; nx = cnt > 0u ? cnt : 1u;
}
__device__ __forceinline__ void xcd_barrier(const XcdBarrier& b) {
    asm volatile("s_waitcnt vmcnt(0)" ::: "memory");
    __syncthreads();
    if (threadIdx.x == 0) {
        unsigned* bar = b.bar;
        __builtin_amdgcn_s_waitcnt(0);
        unsigned nloc = b.st[0], nx = b.st[1];
        if (nloc == 0u) { xcd_barrier_complete(bar, b.x, nloc, nx); b.st[0] = nloc; b.st[1] = nx; }
        const unsigned old = xb_add(&bar[XB_XSUB(b.x)], 1u);
        const unsigned gen = old / nloc;
        if (old + 1u == (gen + 1u) * nloc) {
            __builtin_amdgcn_fence(__ATOMIC_RELEASE, "agent");
            asm volatile("s_waitcnt vmcnt(0)" ::: "memory");
            const unsigned og = xb_add(&bar[XB_TOP], 1u);
            const unsigned tg = og / nx;
            if (og + 1u == (tg + 1u) * nx) xb_add(&bar[XB_TOPGEN], 1u);
            else XB_SPIN(xb_ld(&bar[XB_TOPGEN]) == tg, bar);
            __builtin_amdgcn_fence(__ATOMIC_ACQUIRE, "agent");
            xb_add(&bar[XB_XGEN(b.x)], 1u);
            asm volatile("s_waitcnt vmcnt(0)" ::: "memory");
        } else {
            XB_SPIN(xb_ld(&bar[XB_XGEN(b.x)]) == gen, bar);
            __builtin_amdgcn_fence(__ATOMIC_ACQUIRE, "agent");
            asm volatile("s_waitcnt vmcnt(0)" ::: "memory");
        }
    }
    __syncthreads();
}

__device__ __forceinline__ int fresh_tid() { int t = threadIdx.x; asm volatile("" : "+v"(t)); return t; }
__device__ __forceinline__ float wave_sum(float v) {
#pragma unroll
  for (int o = 32; o > 0; o >>= 1) v += __shfl_xor(v, o, 64);
  return v;
}
__device__ __forceinline__ float sigmoidf_(float x) { return 1.0f / (1.0f + __expf(-x)); }
__device__ __forceinline__ float siluf_(float x) { return x / (1.0f + __expf(-x)); }
__device__ __forceinline__ float gelu_tanh(float x) {
  float u = 0.7978845608028654f * (x + 0.044715f * x * x * x);
  float t = 1.0f - 2.0f / (__expf(2.0f * u) + 1.0f);
  return 0.5f * x * (1.0f + t);
}

constexpr int T0_NORM = L / 4;
constexpr int T0_WIN = (D / 64) * (NP / 64);
constexpr int T0_WATT = (1024 / 64) * (2048 / 64);
constexpr int T0_WGLU = (512 / 64) * (512 / 64);
constexpr int T0_WSSM = (512 / 64) * (2048 / 64);
constexpr int T0_WOUT = (2048 / 64) * (2048 / 64);
constexpr int T0_ROT = (L * 24) / 256;
constexpr int T0_SSM = 8;
constexpr int T0_TOTAL = T0_NORM + T0_WIN + T0_WATT + T0_WGLU + T0_WSSM + T0_WOUT + T0_ROT + T0_SSM;

__device__ __forceinline__ int remap_col(int np) {
  if (np < 3648) return np;
  if (np < 8768) return np + 16;
  if (np < 8784) return np - 8768 + 3648;
  return -1;
}

__device__ __forceinline__ void transpose_tile(const float* __restrict__ W, int K, int N, half_t* __restrict__ Wt,
                               int kt, int nt, bool remap, char* smem) {
  half_t* t = (half_t*)smem;
  const int tid = fresh_tid();
  {
    const int nn = tid & 63;
    const int np = nt * 64 + nn;
    const int n = remap ? remap_col(np) : np;
    const int nc = n >= 0 ? n : 0;
    float wv[16];
#pragma unroll
    for (int i = 0; i < 16; ++i) wv[i] = W[(size_t)(kt * 64 + (tid >> 6) + 4 * i) * N + nc];
    asm volatile("" ::: "memory");
#pragma unroll
    for (int i = 0; i < 16; ++i) t[nn * 66 + (tid >> 6) + 4 * i] = (half_t)(n >= 0 ? wv[i] : 0.0f);
  }
  __syncthreads();
#pragma unroll 4
  for (int i = 0; i < 8; ++i) {
    int e = tid + 256 * i;
    int nn = e >> 5, kp = e & 31;
    half2v v; v.x = t[nn * 66 + kp * 2]; v.y = t[nn * 66 + kp * 2 + 1];
    *(half2v*)(Wt + (size_t)(nt * 64 + nn) * K + kt * 64 + kp * 2) = v;
  }
  __syncthreads();
}

__device__ __forceinline__ void prep_task(const Params& P, int t, char* smem) {
  const int tid = fresh_tid(), lane = tid & 63, wave = tid >> 6;
  if (t < T0_NORM) {
    int row = t * 4 + wave;
    const float4* xr = (const float4*)(P.x + (size_t)row * D);
    float4 v[8]; float ss = 0.f;
#pragma unroll
    for (int j = 0; j < 8; ++j) { v[j] = xr[j * 64 + lane]; ss += v[j].x * v[j].x + v[j].y * v[j].y + v[j].z * v[j].z + v[j].w * v[j].w; }
    ss = wave_sum(ss);
    float sc = rsqrtf(ss * (1.0f / D) + 1e-6f);
    const float4* g4 = (const float4*)P.g_norm;
#pragma unroll
    for (int j = 0; j < 8; ++j) {
      float4 g = g4[j * 64 + lane];
      half4 o; o.x = (half_t)(v[j].x * sc * g.x); o.y = (half_t)(v[j].y * sc * g.y);
      o.z = (half_t)(v[j].z * sc * g.z); o.w = (half_t)(v[j].w * sc * g.w);
      *(half4*)(P.h() + (size_t)row * D + (j * 64 + lane) * 4) = o;
    }
    return;
  }
  t -= T0_NORM;
  if (t < T0_WIN) { transpose_tile(P.w_in, D, NIN, P.wt_in(), t % 32, t / 32, true, smem); return; }
  t -= T0_WIN;
  if (t < T0_WATT) { transpose_tile(P.w_att_out, 1024, 2048, P.wt_att(), t % 16, t / 16, false, smem); return; }
  t -= T0_WATT;
  if (t < T0_WGLU) { transpose_tile(P.w_glu, 512, 512, P.wt_glu(), t % 8, t / 8, false, smem); return; }
  t -= T0_WGLU;
  if (t < T0_WSSM) { transpose_tile(P.w_ssm_out, 512, 2048, P.wt_ssm(), t % 8, t / 8, false, smem); return; }
  t -= T0_WSSM;
  if (t < T0_WOUT) { transpose_tile(P.w_out, 2048, 2048, P.wt_out(), t % 32, t / 32, false, smem); return; }
  t -= T0_WOUT;
  if (t < T0_ROT) {
    int e = t * 256 + tid;
    int tok = e / 24, i = e % 24;
    float a;
    if (i < 16) { a = (-13.122363377404328f) * (float)i; a = a * (2.0f / 32.0f); }
    else        { a = (-13.122363377404328f) * (float)(i - 16); a = a * (2.0f / 16.0f); }
    float inv = expf(a);
    float ang = (float)P.pos[tok] * inv;
    double rev = (double)ang * 0.15915494309189535;
    rev = rev - rint(rev);
    float fr = (float)rev;
    float s = __builtin_amdgcn_sinf(fr);
    float c = __builtin_amdgcn_cosf(fr);
    if (i < 16) { P.cos128()[tok * 16 + i] = c; P.sin128()[tok * 16 + i] = s; }
    else        { P.cos64()[tok * 8 + i - 16] = c; P.sin64()[tok * 8 + i - 16] = s; }
    return;
  }
  t -= T0_ROT;
  {
    int gp = t * 256 + tid;
    int g = gp >> 6, p = gp & 63;
    float dt = expf(P.log_dt[g]);
    float ar = P.a_re[gp], ai = P.a_im[gp];
    float mag = expf(ar * dt);
    float ang = ai * dt;
    double rev = (double)ang * 0.15915494309189535;
    rev = rev - rint(rev);
    float fr = (float)rev;
    float lr = mag * __builtin_amdgcn_cosf(fr);
    float li = mag * __builtin_amdgcn_sinf(fr);
    float den = ar * ar + ai * ai;
    float cr = ((lr - 1.0f) * ar + li * ai) / den;
    float ci = (li * ar - (lr - 1.0f) * ai) / den;
    P.lam()[gp * 2] = lr; P.lam()[gp * 2 + 1] = li;
    for (int c = 0; c < 16; ++c) {
      float br = P.b_re[gp * 16 + c], bi = P.b_im[gp * 16 + c];
      P.bb()[gp * 32 + c] = cr * br - ci * bi;
      P.bb()[gp * 32 + 16 + c] = cr * bi + ci * br;
      P.cmT()[(g * 16 + c) * 128 + p] = (half_t)P.c_re[(g * 16 + c) * 64 + p];
      P.cmT()[(g * 16 + c) * 128 + 64 + p] = (half_t)(-P.c_im[(g * 16 + c) * 64 + p]);
    }
  }
}

constexpr int LDS_ROW = 144;
constexpr int LDS_TILE = 128 * LDS_ROW;
constexpr int LDS_STAGE = 2 * LDS_TILE;

__device__ __forceinline__ void gemm_loop(const half_t* __restrict__ A, int lda, const half_t* __restrict__ B,
                                          int ldb, int K, int m0, int n0, f32x16 (&acc)[2][2], char* smem) {
  const int tid = fresh_tid(), lane = tid & 63, wave = tid >> 6;
  const int wm = wave >> 1, wn = wave & 1;
  const int lrow = tid >> 3, lkc = tid & 7;
  const half_t* ga = A + (size_t)(m0 + lrow) * lda + lkc * 8;
  const half_t* gb = B + (size_t)(n0 + lrow) * ldb + lkc * 8;
  u32x4 ra[4], rb[4];
  const int KT = K >> 6;
#pragma unroll
  for (int i = 0; i < 4; ++i) {
    ra[i] = *(const u32x4*)(ga + (size_t)(32 * i) * lda);
    rb[i] = *(const u32x4*)(gb + (size_t)(32 * i) * ldb);
  }
  const int arow = (wm * 64 + (lane & 31)) * LDS_ROW + (lane >> 5) * 16;
  const int brow = LDS_TILE + (wn * 64 + (lane & 31)) * LDS_ROW + (lane >> 5) * 16;
  for (int kt = 0; kt < KT; ++kt) {
    __syncthreads();
#pragma unroll
    for (int i = 0; i < 4; ++i) {
      *(u32x4*)(smem + (lrow + 32 * i) * LDS_ROW + lkc * 16) = ra[i];
      *(u32x4*)(smem + LDS_TILE + (lrow + 32 * i) * LDS_ROW + lkc * 16) = rb[i];
    }
    {
      const int kn = (kt + 1 < KT) ? kt + 1 : kt;
#pragma unroll
      for (int i = 0; i < 4; ++i) {
        ra[i] = *(const u32x4*)(ga + (size_t)(32 * i) * lda + kn * 64);
        rb[i] = *(const u32x4*)(gb + (size_t)(32 * i) * ldb + kn * 64);
      }
    }
    __syncthreads();
#pragma unroll
    for (int ks = 0; ks < 4; ++ks) {
      half8 a0 = *(const half8*)(smem + arow + ks * 32);
      half8 a1 = *(const half8*)(smem + arow + 32 * LDS_ROW + ks * 32);
      half8 b0 = *(const half8*)(smem + brow + ks * 32);
      half8 b1 = *(const half8*)(smem + brow + 32 * LDS_ROW + ks * 32);
      acc[0][0] = __builtin_amdgcn_mfma_f32_32x32x16_f16(a0, b0, acc[0][0], 0, 0, 0);
      acc[0][1] = __builtin_amdgcn_mfma_f32_32x32x16_f16(a0, b1, acc[0][1], 0, 0, 0);
      acc[1][0] = __builtin_amdgcn_mfma_f32_32x32x16_f16(a1, b0, acc[1][0], 0, 0, 0);
      acc[1][1] = __builtin_amdgcn_mfma_f32_32x32x16_f16(a1, b1, acc[1][1], 0, 0, 0);
      if (ks & 1) asm volatile("" ::: "memory");
    }
  }
  __builtin_amdgcn_sched_barrier(0);
  __syncthreads();
  __builtin_amdgcn_sched_barrier(0);
}

#define ACC_ROW(mt, i) (wm * 64 + (mt) * 32 + ((i) & 3) + 8 * ((i) >> 2) + 4 * (lane >> 5))
#define ACC_COL(nt) (wn * 64 + (nt) * 32 + (lane & 31))

constexpr int CS_STRIDE = 136;

__device__ __forceinline__ void tile_coords(int t, int NT, int& mt, int& nt) {
  int per = 16 * NT;
  int grp = t / per, r = t - grp * per;
  nt = r >> 4; mt = grp * 16 + (r & 15);
}

__device__ __forceinline__ void g1_tile(const Params& P, int mt, int nt, char* smem) {
  const int tid = fresh_tid(), lane = tid & 63, wave = tid >> 6;
  const int wm = wave >> 1, wn = wave & 1;
  const int m0 = mt * 128, n0 = nt * 128;
  f32x16 acc[2][2];
#pragma unroll
  for (int a = 0; a < 2; ++a)
#pragma unroll
    for (int b = 0; b < 2; ++b)
#pragma unroll
      for (int i = 0; i < 16; ++i) acc[a][b][i] = 0.f;
  gemm_loop(P.h(), D, P.wt_in(), D, D, m0, n0, acc, smem);
  half_t* cs = (half_t*)smem;
  half_t* csw = cs + (wm * 64 + 4 * (lane >> 5)) * CS_STRIDE + wn * 64 + (lane & 31);
#pragma unroll
  for (int a = 0; a < 2; ++a)
#pragma unroll
    for (int b = 0; b < 2; ++b) {
      const float sc = (n0 + ACC_COL(b) >= C_WI) ? (1.0f / 32.0f) : 1.0f;
#pragma unroll
      for (int i = 0; i < 16; ++i) csw[(a * 32 + (i & 3) + 8 * (i >> 2)) * CS_STRIDE + b * 32] = (half_t)(acc[a][b][i] * sc);
    }
  __syncthreads();
#pragma unroll 2
  for (int i = 0; i < 8; ++i) {
    int c = tid + 256 * i;
    int row = c >> 4, cc = (c & 15) * 8;
    int n = n0 + cc, m = m0 + row;
    half8 v = *(const half8*)(cs + row * CS_STRIDE + cc);
    if (n < C_V) {
      int d = n & 127;
      if (d < 32) {
        const bool lo = d < 16;
        half8 o = *(const half8*)(cs + row * CS_STRIDE + (lo ? cc + 16 : cc - 16));
        const int fi = lo ? d : d - 16;
        const float* cp = P.cos128() + (size_t)m * 16 + fi;
        const float* sp = P.sin128() + (size_t)m * 16 + fi;
        half8 r;
#pragma unroll
        for (int j = 0; j < 8; ++j) {
          float cv = cp[j], sv = sp[j];
          float x1 = lo ? (float)v[j] : (float)o[j];
          float x2 = lo ? (float)o[j] : (float)v[j];
          r[j] = (half_t)(lo ? (x1 * cv - x2 * sv) : (x2 * cv + x1 * sv));
        }
        v = r;
      }
    } else if (n >= C_QI && n < C_U) {
      int d = n & 63;
      if (d < 16) {
        const bool lo = d < 8;
        half8 o = *(const half8*)(cs + row * CS_STRIDE + (lo ? cc + 8 : cc - 8));
        const float* cp = P.cos64() + (size_t)m * 8;
        const float* sp = P.sin64() + (size_t)m * 8;
        half8 r;
#pragma unroll
        for (int j = 0; j < 8; ++j) {
          float cv = cp[j], sv = sp[j];
          float x1 = lo ? (float)v[j] : (float)o[j];
          float x2 = lo ? (float)o[j] : (float)v[j];
          r[j] = (half_t)(lo ? (x1 * cv - x2 * sv) : (x2 * cv + x1 * sv));
        }
        v = r;
      }
    }
    if (n >= C_KI && n < C_U) *(half8*)(P.kidx() + (size_t)m * 64 + (n - C_KI)) = v;
    else *(half8*)(P.proj() + (size_t)m * NP + n) = v;
  }
}

__device__ __forceinline__ void g3_tile(const Params& P, int mt, int nt, char* smem) {
  const int tid = fresh_tid(), lane = tid & 63, wave = tid >> 6;
  const int wm = wave >> 1, wn = wave & 1;
  const int m0 = mt * 128, n0 = nt * 128;
  f32x16 acc[2][2];
#pragma unroll
  for (int a = 0; a < 2; ++a)
#pragma unroll
    for (int b = 0; b < 2; ++b)
#pragma unroll
      for (int i = 0; i < 16; ++i) acc[a][b][i] = 0.f;
  gemm_loop(P.s1(), 512, P.wt_glu(), 512, 512, m0, n0, acc, smem);
  half_t* cs = (half_t*)smem;
  half_t* csw = cs + (wm * 64 + 4 * (lane >> 5)) * CS_STRIDE + wn * 64 + (lane & 31);
#pragma unroll
  for (int a = 0; a < 2; ++a)
#pragma unroll
    for (int b = 0; b < 2; ++b) {
      const int col = ACC_COL(b);
      const int n = n0 + col;
      const float bg = P.b_glu[n];
#pragma unroll
      for (int i0 = 0; i0 < 16; i0 += 8) {
        half_t s1h[8], gth[8];
#pragma unroll
        for (int i = 0; i < 8; ++i) {
          const size_t m = m0 + ACC_ROW(a, i0 + i);
          s1h[i] = P.s1()[m * 512 + n];
          gth[i] = P.proj()[m * NP + C_SG + n];
        }
        asm volatile("" ::: "memory");
#pragma unroll
        for (int i = 0; i < 8; ++i) {
          float v = (float)s1h[i] * sigmoidf_(acc[a][b][i0 + i] + bg) * siluf_((float)gth[i]);
          csw[(a * 32 + ((i0 + i) & 3) + 8 * ((i0 + i) >> 2)) * CS_STRIDE + b * 32] = (half_t)v;
        }
      }
    }
  __syncthreads();
#pragma unroll 2
  for (int i = 0; i < 8; ++i) {
    int c = tid + 256 * i;
    int row = c >> 4, cc = (c & 15) * 8;
    *(half8*)(P.sg() + (size_t)(m0 + row) * 512 + n0 + cc) = *(const half8*)(cs + row * CS_STRIDE + cc);
  }
}

template <int WHICH>
__device__ __forceinline__ void g24_tile(const Params& P, int mt, int nt, char* smem) {
  const int tid = fresh_tid(), lane = tid & 63, wave = tid >> 6;
  const int wm = wave >> 1, wn = wave & 1;
  const int m0 = mt * 128, n0 = nt * 128;
  f32x16 acc[2][2];
#pragma unroll
  for (int a = 0; a < 2; ++a)
#pragma unroll
    for (int b = 0; b < 2; ++b)
#pragma unroll
      for (int i = 0; i < 16; ++i) acc[a][b][i] = 0.f;
  if (WHICH == 0) gemm_loop(P.attg(), 1024, P.wt_att(), 1024, 1024, m0, n0, acc, smem);
  else            gemm_loop(P.sg(), 512, P.wt_ssm(), 512, 512, m0, n0, acc, smem);
  half_t* cs = (half_t*)smem;
#pragma unroll 1
  for (int i = 0; i < 8; ++i) {
    const int c = tid + 256 * i;
    const int row = c >> 4, cc = (c & 15) * 8;
    const half8 gv = *(const half8*)(P.proj() + (size_t)(m0 + row) * NP + C_MG + WHICH * 2048 + n0 + cc);
    const f32x4 ba = *(const f32x4*)(P.b_merge + WHICH * 2048 + n0 + cc), bb4 = *(const f32x4*)(P.b_merge + WHICH * 2048 + n0 + cc + 4);
    asm volatile("" ::: "memory");
    half8 r;
#pragma unroll
    for (int j = 0; j < 8; ++j) r[j] = (half_t)sigmoidf_((float)gv[j] + (j < 4 ? ba[j & 3] : bb4[j & 3]));
    *(half8*)(cs + row * CS_STRIDE + cc) = r;
  }
  __syncthreads();
  half_t* csw = cs + (wm * 64 + 4 * (lane >> 5)) * CS_STRIDE + wn * 64 + (lane & 31);
#pragma unroll
  for (int a = 0; a < 2; ++a)
#pragma unroll
    for (int b = 0; b < 2; ++b) {
#pragma unroll
      for (int i = 0; i < 16; ++i) {
        const int o = (a * 32 + (i & 3) + 8 * (i >> 2)) * CS_STRIDE + b * 32;
        csw[o] = (half_t)(acc[a][b][i] * (float)csw[o]);
      }
      asm volatile("" ::: "memory");
    }
  __syncthreads();
  half_t* mixed = P.h();
#pragma unroll 2
  for (int i = 0; i < 8; ++i) {
    int c = tid + 256 * i;
    int row = c >> 4, cc = (c & 15) * 8;
    half8 v = *(const half8*)(cs + row * CS_STRIDE + cc);
    half_t* dst = mixed + (size_t)(m0 + row) * D + n0 + cc;
    if (WHICH == 1) {
      const half8 pv = *(const half8*)dst;
#pragma unroll
      for (int j = 0; j < 8; ++j) v[j] = (half_t)((float)v[j] + (float)pv[j]);
    }
    *(half8*)dst = v;
  }
}

__device__ __forceinline__ void g5_tile(const Params& P, int mt, int nt, char* smem) {
  const int tid = fresh_tid(), lane = tid & 63, wave = tid >> 6;
  const int wm = wave >> 1, wn = wave & 1;
  const int m0 = mt * 128, n0 = nt * 128;
  f32x16 acc[2][2];
#pragma unroll
  for (int a = 0; a < 2; ++a)
#pragma unroll
    for (int b = 0; b < 2; ++b)
#pragma unroll
      for (int i = 0; i < 16; ++i) acc[a][b][i] = 0.f;
  gemm_loop(P.h(), D, P.wt_out(), D, D, m0, n0, acc, smem);
#pragma unroll
  for (int a = 0; a < 2; ++a)
#pragma unroll
    for (int b = 0; b < 2; ++b) {
      const int n = n0 + ACC_COL(b);
      float xv[16];
#pragma unroll
      for (int i = 0; i < 16; ++i) xv[i] = P.x[(size_t)(m0 + ACC_ROW(a, i)) * D + n];
      asm volatile("" ::: "memory");
#pragma unroll
      for (int i = 0; i < 16; ++i) P.out[(size_t)(m0 + ACC_ROW(a, i)) * D + n] = xv[i] + acc[a][b][i];
    }
}

__device__ __forceinline__ void fn_task(const Params& P, int t) {
  const int tid = fresh_tid(), lane = tid & 63, wave = tid >> 6;
  int row = t * 4 + wave;
  float4* xr = (float4*)(P.out + (size_t)row * D);
  float4 v[8]; float ss = 0.f;
#pragma unroll
  for (int j = 0; j < 8; ++j) { v[j] = xr[j * 64 + lane]; ss += v[j].x * v[j].x + v[j].y * v[j].y + v[j].z * v[j].z + v[j].w * v[j].w; }
  ss = wave_sum(ss);
  float sc = rsqrtf(ss * (1.0f / D) + 1e-6f);
  const float4* g4 = (const float4*)P.g_final;
#pragma unroll
  for (int j = 0; j < 8; ++j) {
    float4 g = g4[j * 64 + lane];
    float4 o; o.x = v[j].x * sc * g.x; o.y = v[j].y * sc * g.y; o.z = v[j].z * sc * g.z; o.w = v[j].w * sc * g.w;
    xr[j * 64 + lane] = o;
  }
}

__device__ __forceinline__ void ssm_local(const Params& P, int item, char* smem, bool final_pass) {
  const int tid = fresh_tid(), lane = tid & 63, wave = tid >> 6;
  const int it = item * 4 + wave;
  const int n = it >> 5, g = it & 31;
  half_t* ub = (half_t*)(smem + wave * 2048);
  half_t* xs = (half_t*)(smem + 8192 + wave * 8192);
  __syncthreads();
  {
    const u32x4* src = (const u32x4*)(P.proj() + (size_t)(n * 64 + lane) * NP + C_U + g * 16);
    u32x4 u0 = src[0], u1 = src[1];
    *(u32x4*)(ub + lane * 16) = u0;
    *(u32x4*)(ub + lane * 16 + 8) = u1;
  }
  const int gp = g * 64 + lane;
  float bre[16], bim[16];
  {
    const float4* b4 = (const float4*)(P.bb() + (size_t)gp * 32);
#pragma unroll
    for (int j = 0; j < 4; ++j) { float4 v = b4[j]; bre[4 * j] = v.x; bre[4 * j + 1] = v.y; bre[4 * j + 2] = v.z; bre[4 * j + 3] = v.w; }
#pragma unroll
    for (int j = 0; j < 4; ++j) { float4 v = b4[4 + j]; bim[4 * j] = v.x; bim[4 * j + 1] = v.y; bim[4 * j + 2] = v.z; bim[4 * j + 3] = v.w; }
  }
  const float lr = P.lam()[gp * 2], li = P.lam()[gp * 2 + 1];
  float xr = 0.f, xi = 0.f;
  if (final_pass) { xr = P.E()[((size_t)n * 2048 + gp) * 2]; xi = P.E()[((size_t)n * 2048 + gp) * 2 + 1]; }
  __syncthreads();
  half8 bf[4];
  float dsk = 0.f;
  if (final_pass) {
#pragma unroll
    for (int ks = 0; ks < 4; ++ks)
      bf[ks] = *(const half8*)(P.cmT() + (size_t)(g * 16 + (lane & 15)) * 128 + ks * 32 + (lane >> 4) * 8);
    dsk = P.ssm_d[g * 16 + (lane & 15)];
  }
#pragma unroll 1
  for (int hb = 0; hb < 2; ++hb) {
#pragma unroll 2
    for (int tl = 0; tl < 32; ++tl) {
      const int tk = hb * 32 + tl;
      half8 ua = *(const half8*)(ub + tk * 16);
      half8 uc = *(const half8*)(ub + tk * 16 + 8);
      float br = 0.f, bi = 0.f;
#pragma unroll
      for (int c = 0; c < 8; ++c) { float uv = (float)ua[c]; br += bre[c] * uv; bi += bim[c] * uv; }
#pragma unroll
      for (int c = 0; c < 8; ++c) { float uv = (float)uc[c]; br += bre[8 + c] * uv; bi += bim[8 + c] * uv; }
      float nr = lr * xr - li * xi + br;
      float ni = lr * xi + li * xr + bi;
      xr = nr; xi = ni;
      if (final_pass) {
        xs[tl * 128 + lane] = (half_t)xr;
        xs[tl * 128 + 64 + lane] = (half_t)xi;
      }
    }
    if (final_pass) {
#pragma unroll
      for (int rt = 0; rt < 2; ++rt) {
        f32x4 y = {0.f, 0.f, 0.f, 0.f};
#pragma unroll
        for (int ks = 0; ks < 4; ++ks) {
          half8 af = *(const half8*)(xs + (rt * 16 + (lane & 15)) * 128 + ks * 32 + (lane >> 4) * 8);
          y = __builtin_amdgcn_mfma_f32_16x16x32_f16(af, bf[ks], y, 0, 0, 0);
        }
#pragma unroll
        for (int i = 0; i < 4; ++i) {
          int tk = hb * 32 + rt * 16 + (lane >> 4) * 4 + i;
          float uv = (float)ub[tk * 16 + (lane & 15)];
          float yv = y[i] + dsk * uv;
          P.s1()[(size_t)(n * 64 + tk) * 512 + g * 16 + (lane & 15)] = (half_t)gelu_tanh(yv);
        }
      }
    }
  }
  if (!final_pass) {
    P.E()[((size_t)n * 2048 + gp) * 2] = xr;
    P.E()[((size_t)n * 2048 + gp) * 2 + 1] = xi;
  }
}

__device__ __forceinline__ void ssm_carry(const Params& P, int blk) {
  const int gp = blk * 256 + fresh_tid();
  float lr = P.lam()[gp * 2], li = P.lam()[gp * 2 + 1];
#pragma unroll
  for (int s = 0; s < 6; ++s) { float nr = lr * lr - li * li; float ni = 2.0f * lr * li; lr = nr; li = ni; }
  float sr = 0.f, si = 0.f;
  float2* Ep = (float2*)P.E();
  for (int n0 = 0; n0 < 256; n0 += 32) {
    float2 e[32];
#pragma unroll
    for (int u = 0; u < 32; ++u) e[u] = Ep[(size_t)(n0 + u) * 2048 + gp];
    asm volatile("" ::: "memory");
#pragma unroll
    for (int u = 0; u < 32; ++u) {
      Ep[(size_t)(n0 + u) * 2048 + gp] = make_float2(sr, si);
      float nr = lr * sr - li * si + e[u].x;
      float ni = lr * si + li * sr + e[u].y;
      sr = nr; si = ni;
    }
  }
}

constexpr int QROW = 2080;

__device__ __forceinline__ void idx_score_item(const Params& P, int band, int item, char* smem) {
  const int tid = fresh_tid(), lane = tid & 63, wave = tid >> 6;
  const int nqt = band_rows(band) >> 4;
  const int qt = item % nqt, piece = item / nqt;
  const int q0 = band_q0(band) + qt * 16;
  const int sstride = band_stride(band);
  const int nadm = 64 * ((q0 >> 6) + 1);
  const int k0 = piece * KP;
  if (k0 >= nadm) return;
  const int kend = min(k0 + KP, nadm);
  __syncthreads();
  {
    u32x4 qv[8];
#pragma unroll
    for (int i = 0; i < 8; ++i) {
      const int c = tid + 256 * i;
      qv[i] = *(const u32x4*)(P.proj() + (size_t)(q0 + (c >> 7)) * NP + C_QI + (c & 127) * 8);
    }
    asm volatile("" ::: "memory");
#pragma unroll
    for (int i = 0; i < 8; ++i) {
      const int c = tid + 256 * i;
      *(u32x4*)(smem + (c >> 7) * QROW + (c & 127) * 16) = qv[i];
    }
  }
  float* wl = (float*)(smem + 16 * QROW);
  if (tid < 32) {
    const half8 wv = *(const half8*)(P.proj() + (size_t)(q0 + (tid & 15)) * NP + C_WI + (tid >> 4) * 8);
#pragma unroll
    for (int j = 0; j < 8; ++j) wl[((tid >> 4) * 8 + j) * 16 + (tid & 15)] = (float)wv[j];
  }
  __syncthreads();
  float* S = P.out;
  const char* qbase = smem + (lane & 15) * QROW + (lane >> 4) * 16;
  for (int slab = k0 + wave * 64; slab < kend; slab += 256) {
    half8 kf[4][2];
#pragma unroll
    for (int st = 0; st < 4; ++st)
#pragma unroll
      for (int ks = 0; ks < 2; ++ks)
        kf[st][ks] = *(const half8*)(P.kidx() + (size_t)(slab + st * 16 + (lane & 15)) * 64 + ks * 32 + (lane >> 4) * 8);
    f32x4 acc[4];
#pragma unroll
    for (int st = 0; st < 4; ++st) acc[st] = f32x4{0.f, 0.f, 0.f, 0.f};
#pragma unroll 2
    for (int h = 0; h < 16; ++h) {
      const float wh = wl[h * 16 + (lane & 15)];
      const half8 q0f = *(const half8*)(qbase + h * 128);
      const half8 q1f = *(const half8*)(qbase + h * 128 + 64);
      f32x4 lg[4];
#pragma unroll
      for (int st = 0; st < 4; ++st) {
        lg[st] = f32x4{0.f, 0.f, 0.f, 0.f};
        lg[st] = __builtin_amdgcn_mfma_f32_16x16x32_f16(kf[st][0], q0f, lg[st], 0, 0, 0);
        lg[st] = __builtin_amdgcn_mfma_f32_16x16x32_f16(kf[st][1], q1f, lg[st], 0, 0, 0);
      }
#pragma unroll
      for (int st = 0; st < 4; ++st)
#pragma unroll
        for (int i = 0; i < 4; ++i) {
          float rl = __int_as_float(max(__float_as_int(lg[st][i]), 0));
          asm("" : "+v"(rl));
          acc[st][i] = __builtin_fmaf(rl, wh, acc[st][i]);
        }
    }
    float* srow = S + (size_t)(qt * 16 + (lane & 15)) * sstride + slab + 4 * (lane >> 4);
#pragma unroll
    for (int st = 0; st < 4; ++st) *(f32x4*)(srow + st * 16) = acc[st];
  }
}

__device__ __forceinline__ unsigned mono_key(float f) {
  unsigned u = __float_as_uint(f);
  return (u & 0x80000000u) ? ~u : (u | 0x80000000u);
}

__device__ __forceinline__ int wave_scan_add_i(int v) {
  v += __builtin_amdgcn_update_dpp(0, v, 0x111, 0xf, 0xf, true);
  v += __builtin_amdgcn_update_dpp(0, v, 0x112, 0xf, 0xf, true);
  v += __builtin_amdgcn_update_dpp(0, v, 0x114, 0xf, 0xf, true);
  v += __builtin_amdgcn_update_dpp(0, v, 0x118, 0xf, 0xf, true);
  v += __builtin_amdgcn_update_dpp(0, v, 0x142, 0xa, 0xf, false);
  v += __builtin_amdgcn_update_dpp(0, v, 0x143, 0xc, 0xf, false);
  return v;
}

template <int NV, int R>
__device__ __forceinline__ void select_rows(const float* __restrict__ S0, int sstride, int n, unsigned short* __restrict__ sel0,
                                            int* red, int tid, int lane, int wave) {
  unsigned v[R][NV];
#pragma unroll
  for (int r = 0; r < R; ++r)
#pragma unroll
    for (int j = 0; j < NV; ++j)
      v[r][j] = __float_as_uint(S0[(size_t)r * sstride + j * 256 + tid]);
  asm volatile("" ::: "memory");
#pragma unroll
  for (int r = 0; r < R; ++r)
#pragma unroll
    for (int j = 0; j < NV; ++j) {
      const unsigned u = v[r][j];
      const unsigned k = (u & 0x80000000u) ? ~u : (u | 0x80000000u);
      v[r][j] = (j * 256 + tid < n) ? k : 0u;
    }
  unsigned T[R], thr[R]; bool done[R];
#pragma unroll
  for (int r = 0; r < R; ++r) { T[r] = 0u; thr[r] = 0u; done[r] = false; }
  for (int bit = 31; bit >= 0; --bit) {
    int* slot = red + ((bit & 1) << 4);
#pragma unroll
    for (int r = 0; r < R; ++r) {
      if (!done[r]) {
        const unsigned cand = T[r] | (1u << bit);
        int cnt = 0;
#pragma unroll
        for (int j = 0; j < NV; ++j) cnt += (v[r][j] >= cand) ? 1 : 0;
        cnt = wave_scan_add_i(cnt);
        if (lane == 63) slot[r * 4 + wave] = cnt;
      }
    }
    __syncthreads();
    bool all_done = true;
#pragma unroll
    for (int r = 0; r < R; ++r) {
      if (!done[r]) {
        const int total = slot[r * 4] + slot[r * 4 + 1] + slot[r * 4 + 2] + slot[r * 4 + 3];
        if (total >= 256) { T[r] |= (1u << bit); if (total == 256) { done[r] = true; thr[r] = T[r]; } }
      }
      all_done = all_done && done[r];
    }
    if (all_done) break;
  }
  const unsigned long long lt = (lane == 0) ? 0ull : (~0ull >> (64 - lane));
  int* pre = red + 32;
#pragma unroll
  for (int r = 0; r < R; ++r) {
    const bool exact = done[r];
    const unsigned th = exact ? thr[r] : (T[r] + 1u);
    int cl = 0;
#pragma unroll
    for (int j = 0; j < NV; ++j) cl += (v[r][j] >= th) ? 1 : 0;
    const int incl = wave_scan_add_i(cl);
    const int wtot = __builtin_amdgcn_readlane(incl, 63);
    __syncthreads();
    if (lane == 0) pre[wave] = wtot;
    __syncthreads();
    int base = incl - cl, tot = 0;
#pragma unroll
    for (int w2 = 0; w2 < 4; ++w2) { int c = pre[w2]; if (w2 < wave) base += c; tot += c; }
    unsigned short* selq = sel0 + (size_t)r * 256;
#pragma unroll
    for (int j = 0; j < NV; ++j) {
      if (v[r][j] >= th) { selq[base] = (unsigned short)(j * 256 + tid); ++base; }
    }
    if (!exact && wave == 0) {
      const int need_eq = 256 - tot;
      const float* S = S0 + (size_t)r * sstride;
      int filled = 0;
      for (int i0 = 0; i0 < n && filled < need_eq; i0 += 64) {
        const unsigned key = mono_key(S[i0 + lane]);
        const bool e = (key == T[r]);
        const unsigned long long m = __ballot(e);
        const int pos = filled + __popcll(m & lt);
        if (e && pos < need_eq) selq[tot + pos] = (unsigned short)(i0 + lane);
        filled += __popcll(m);
      }
    }
  }
}

__device__ __forceinline__ void idx_select_group(const Params& P, int band, int grp, char* smem) {
  const int tid = fresh_tid(), lane = tid & 63, wave = tid >> 6;
  const int r0 = grp * 4;
  const int q0 = band_q0(band) + r0;
  const int sstride = band_stride(band);
  const int n = 64 * ((q0 >> 6) + 1);
  unsigned short* sel0 = P.sel() + (size_t)q0 * 256;
  if (n <= 256) {
#pragma unroll
    for (int r = 0; r < 4; ++r) sel0[r * 256 + tid] = (unsigned short)(tid < n ? tid : 0);
    return;
  }
  int* red = (int*)smem;
  const float* S0 = P.out + (size_t)r0 * sstride;
  const int nfull = (n + 255) >> 8;
  if (nfull <= 8) select_rows<8, 4>(S0, sstride, n, sel0, red, tid, lane, wave);
  else if (nfull <= 16) select_rows<16, 4>(S0, sstride, n, sel0, red, tid, lane, wave);
  else if (nfull <= 24) {
    select_rows<24, 2>(S0, sstride, n, sel0, red, tid, lane, wave);
    __syncthreads();
    select_rows<24, 2>(S0 + 2 * (size_t)sstride, sstride, n, sel0 + 512, red, tid, lane, wave);
  } else if (nfull <= 32) {
    select_rows<32, 2>(S0, sstride, n, sel0, red, tid, lane, wave);
    __syncthreads();
    select_rows<32, 2>(S0 + 2 * (size_t)sstride, sstride, n, sel0 + 512, red, tid, lane, wave);
  } else if (nfull <= 48) {
#pragma unroll 1
    for (int r = 0; r < 4; ++r) {
      select_rows<48, 1>(S0 + r * (size_t)sstride, sstride, n, sel0 + r * 256, red, tid, lane, wave);
      __syncthreads();
    }
  } else {
#pragma unroll 1
    for (int r = 0; r < 4; ++r) {
      select_rows<64, 1>(S0 + r * (size_t)sstride, sstride, n, sel0 + r * 256, red, tid, lane, wave);
      __syncthreads();
    }
  }
}

__device__ __forceinline__ void attn_item(const Params& P, int item, char* smem) {
  const int tid = fresh_tid(), lane = tid & 63, wave = tid >> 6;
  const int gw = item * 4 + wave;
  const int q = gw >> 1, kvh = gw & 1;
  const int nsel = min(256, 64 * ((q >> 6) + 1));
  char* wsm = smem + wave * 6144;
  unsigned short* sidx = (unsigned short*)wsm;
  float* pbuf = (float*)(wsm + 512);
  float* psum = (float*)(wsm + 512 + 4096);
  __syncthreads();
  *(uint2*)(sidx + lane * 4) = *(const uint2*)(P.sel() + (size_t)q * 256 + lane * 4);
  const int hn = lane & 15, kg = lane >> 4;
  half8 qf[4];
#pragma unroll
  for (int ks = 0; ks < 4; ++ks) {
    half8 z = *(const half8*)(P.proj() + (size_t)q * NP + C_Q + (kvh * 4 + (hn & 3)) * 128 + ks * 32 + kg * 8);
    if (hn >= 4) {
#pragma unroll
      for (int j = 0; j < 8; ++j) z[j] = (half_t)0.f;
    }
    qf[ks] = z;
  }
  __syncthreads();
  const float scale = 0.08838834764831845f;
  float mx = -INFINITY;
#pragma unroll
  for (int tg = 0; tg < 8; ++tg) {
    half8 kf[2][4];
#pragma unroll
    for (int t = 0; t < 2; ++t) {
      const int idx = sidx[(tg * 2 + t) * 16 + hn];
      const half_t* kp = P.proj() + (size_t)idx * NP + C_K + kvh * 128 + kg * 8;
#pragma unroll
      for (int ks = 0; ks < 4; ++ks) kf[t][ks] = *(const half8*)(kp + ks * 32);
    }
    asm volatile("" ::: "memory");
#pragma unroll
    for (int t = 0; t < 2; ++t) {
      f32x4 sv = {0.f, 0.f, 0.f, 0.f};
#pragma unroll
      for (int ks = 0; ks < 4; ++ks) sv = __builtin_amdgcn_mfma_f32_16x16x32_f16(kf[t][ks], qf[ks], sv, 0, 0, 0);
#pragma unroll
      for (int i = 0; i < 4; ++i) {
        const int slot = (tg * 2 + t) * 16 + kg * 4 + i;
        const float x = (slot < nsel) ? sv[i] * scale : -INFINITY;
        mx = fmaxf(mx, x);
        if (hn < 4) pbuf[slot * 4 + hn] = x;
      }
    }
  }
  mx = fmaxf(mx, __shfl_xor(mx, 16, 64));
  mx = fmaxf(mx, __shfl_xor(mx, 32, 64));
  float sum = 0.f;
  if (hn < 4) {
#pragma unroll 4
    for (int t = 0; t < 16; ++t)
#pragma unroll
      for (int i = 0; i < 4; ++i) {
        const int slot = t * 16 + kg * 4 + i;
        const float p = __expf(pbuf[slot * 4 + hn] - mx);
        sum += p;
        pbuf[slot * 4 + hn] = p;
      }
  }
  sum += __shfl_xor(sum, 16, 64);
  sum += __shfl_xor(sum, 32, 64);
  if (lane < 4) psum[lane] = sum;
  __syncthreads();
  float o[4][8];
#pragma unroll
  for (int h = 0; h < 4; ++h)
#pragma unroll
    for (int d = 0; d < 8; ++d) o[h][d] = 0.f;
  const half_t* vbase = P.proj() + C_V + kvh * 128 + hn * 8;
  const int nq = nsel >> 2;
  for (int i0 = 0; i0 < nq; i0 += 4) {
    half8 vv[4];
#pragma unroll
    for (int u = 0; u < 4; ++u) {
      const int idx = sidx[4 * (i0 + u) + kg];
      vv[u] = *(const half8*)(vbase + (size_t)idx * NP);
    }
    asm volatile("" ::: "memory");
#pragma unroll
    for (int u = 0; u < 4; ++u) {
      const float4 p4 = *(const float4*)(pbuf + (4 * (i0 + u) + kg) * 4);
#pragma unroll
      for (int d = 0; d < 8; ++d) {
        const float vf = (float)vv[u][d];
        o[0][d] += p4.x * vf; o[1][d] += p4.y * vf; o[2][d] += p4.z * vf; o[3][d] += p4.w * vf;
      }
    }
  }
#pragma unroll
  for (int h = 0; h < 4; ++h)
#pragma unroll
    for (int d = 0; d < 8; ++d) {
      float v = o[h][d];
      v += __shfl_xor(v, 16, 64);
      v += __shfl_xor(v, 32, 64);
      o[h][d] = v;
    }
  {
    const int h = kg;
    const float inv = 1.0f / psum[h];
    const int col = (kvh * 4 + h) * 128 + hn * 8;
    const half8 gt = *(const half8*)(P.proj() + (size_t)q * NP + C_AG + col);
    half8 r;
#pragma unroll
    for (int d = 0; d < 8; ++d) {
      const float ov = (h == 0) ? o[0][d] : (h == 1) ? o[1][d] : (h == 2) ? o[2][d] : o[3][d];
      r[d] = (half_t)(ov * inv * siluf_((float)gt[d]));
    }
    *(half8*)(P.attg() + (size_t)q * 1024 + col) = r;
  }
}

#define FOR_TILES_XCD(NT, CALL)                                                          \
  for (int t = bid; t < 128 * (NT); t += nb) { int mt, nt; tile_coords(t, (NT), mt, nt); CALL; }

__device__ __forceinline__ void run_phase(const Params& P, int ph, char* smem) {
  const int nb = gridDim.x, bid = blockIdx.x;
  if (ph == 0) { for (int t = bid; t < T0_TOTAL; t += nb) prep_task(P, t, smem); }
  else if (ph == 1) { FOR_TILES_XCD(NP / 128, g1_tile(P, mt, nt, smem)) }
  else if (ph == 2) { for (int t = bid; t < 2048; t += nb) ssm_local(P, t, smem, false); }
  else if (ph == 3) { if (bid < 8) ssm_carry(P, bid); }
  else if (ph == 4) { for (int t = bid; t < 2048; t += nb) ssm_local(P, t, smem, true); }
  else if (ph == 5) { for (int t = bid; t < 128 * 4; t += nb) { int mt, nt; tile_coords(t, 4, mt, nt); g3_tile(P, mt, nt, smem); } }
  else if (ph < 22) {
    const int b = (ph - 6) >> 1;
    if (((ph - 6) & 1) == 0) {
      const int nitems = 128 * ((BAND * (b + 1)) / KP);
      for (int t = bid; t < nitems; t += nb) idx_score_item(P, b, t, smem);
    } else {
      for (int t = bid; t < BAND / 4; t += nb) { __syncthreads(); idx_select_group(P, b, t, smem); }
    }
  }
  else if (ph == 22) { for (int t = bid; t < L * 2 / 4; t += nb) attn_item(P, t, smem); }
  else if (ph == 23) { FOR_TILES_XCD(16, { g24_tile<0>(P, mt, nt, smem); g24_tile<1>(P, mt, nt, smem); }) }
  else if (ph == 24) { FOR_TILES_XCD(16, g5_tile(P, mt, nt, smem)) }
  else if (ph == 25) { for (int t = bid; t < L / 4; t += nb) fn_task(P, t); }
}

#if !MEGA
template <int PH>
__global__ void __launch_bounds__(256, 3) k_ph(Params P) {
  __shared__ __attribute__((aligned(16))) char smem[SMEM_BYTES];
  run_phase(P, PH, smem);
}
__global__ void __launch_bounds__(256, 3) k_score(Params P, int b) {
  __shared__ __attribute__((aligned(16))) char smem[SMEM_BYTES];
  const int nb = gridDim.x, bid = blockIdx.x;
  const int nitems = 128 * ((BAND * (b + 1)) / KP);
  for (int t = bid; t < nitems; t += nb) idx_score_item(P, b, t, smem);
}
__global__ void __launch_bounds__(256, 3) k_select(Params P, int b) {
  __shared__ __attribute__((aligned(16))) char smem[SMEM_BYTES];
  const int nb = gridDim.x, bid = blockIdx.x;
  for (int t = bid; t < BAND / 4; t += nb) { __syncthreads(); idx_select_group(P, b, t, smem); }
}

#endif
#if MEGA
__global__ void __launch_bounds__(256, 3) k_mega(Params P) {
  __shared__ __attribute__((aligned(16))) char smem[SMEM_BYTES];
  cg::grid_group grid = cg::this_grid();
  __shared__ uint4 xb_words;
  if (threadIdx.x == 0) xb_words = make_uint4(0u, 0u, 0u, 0u);
  __syncthreads();
  XcdBarrier xb = xcd_barrier_post(P.bar(), (volatile LAS unsigned*)&xb_words);
  if (P.out == nullptr) grid.sync();
  const int nb = gridDim.x, bid = blockIdx.x;
  for (int r = 0; r < REP_P0; ++r) { run_phase(P, 0, smem); xcd_barrier(xb); }
  for (int r = 0; r < REP_G1; ++r) { run_phase(P, 1, smem); xcd_barrier(xb); }
  for (int b = 0; b < NBAND; ++b) {
    {
      const int n_sc = (band_rows(b) >> 4) * ((band_q0(b) + band_rows(b) + KP - 1) / KP);
      const int n_ex = (b == 0 || b == 1) ? 2048 : (b == 2 ? 512 : 0);
      const int n_at = (b >= 1) ? (band_rows(b - 1) * 2 / 4) : 0;
      const int at0 = (b >= 1) ? (band_q0(b - 1) * 2 / 4) : 0;
      for (int t = bid; t < n_sc; t += nb) idx_score_item(P, b, t, smem);
      const int r1 = (bid + nb - (n_sc % nb)) % nb;
      if (b == 0) { for (int u = r1; u < n_ex; u += nb) ssm_local(P, u, smem, false); }
      else if (b == 1) { for (int u = r1; u < n_ex; u += nb) ssm_local(P, u, smem, true); }
      else if (b == 2) { for (int u = r1; u < n_ex; u += nb) { int mt, nt; tile_coords(u, 4, mt, nt); g3_tile(P, mt, nt, smem); } }
      const int r2 = (r1 + nb - (n_ex % nb)) % nb;
      for (int u = r2; u < n_at; u += nb) attn_item(P, at0 + u, smem);
    }
    xcd_barrier(xb);
    if (b == 0 && bid >= nb - 8) ssm_carry(P, bid - (nb - 8));
    else for (int t = bid; t < band_rows(b) / 4; t += (b == 0 ? nb - 8 : nb)) { __syncthreads(); idx_select_group(P, b, t, smem); }
    xcd_barrier(xb);
  }
  for (int t = bid; t < band_rows(NBAND - 1) * 2 / 4; t += nb) attn_item(P, band_q0(NBAND - 1) * 2 / 4 + t, smem);
  xcd_barrier(xb);
  run_phase(P, 23, smem); xcd_barrier(xb);
  for (int r = 0; r < REP_G5; ++r) { run_phase(P, 24, smem); xcd_barrier(xb); }
  run_phase(P, 25, smem);
}
#endif

extern "C" void kernel_launch(void* const* d_in, const int* in_sizes, int n_in, void* d_out, int out_size,
                              void* d_ws, size_t ws_size, hipStream_t stream) {
  Params p{};
  p.x = (const float*)d_in[0]; p.pos = (const int*)d_in[1]; p.g_norm = (const float*)d_in[2];
  p.w_in = (const float*)d_in[3]; p.b_merge = (const float*)d_in[4]; p.a_re = (const float*)d_in[5];
  p.a_im = (const float*)d_in[6]; p.log_dt = (const float*)d_in[7]; p.b_re = (const float*)d_in[8];
  p.b_im = (const float*)d_in[9]; p.c_re = (const float*)d_in[10]; p.c_im = (const float*)d_in[11];
  p.ssm_d = (const float*)d_in[12]; p.w_glu = (const float*)d_in[13]; p.b_glu = (const float*)d_in[14];
  p.w_att_out = (const float*)d_in[15]; p.w_ssm_out = (const float*)d_in[16]; p.w_out = (const float*)d_in[17];
  p.g_final = (const float*)d_in[18];
  p.out = (float*)d_out;
  p.ws = (char*)d_ws;
  size_t off = WS_NEEDED;
  if (off > ws_size) { fprintf(stderr, "workspace too small: need %zu have %zu\n", off, ws_size); return; }
#if MEGA
  static int grid_blocks = 0;
  if (!grid_blocks) {
    int dev = 0, cus = 0, per_cu = 0;
    hipGetDevice(&dev);
    hipDeviceGetAttribute(&cus, hipDeviceAttributeMultiprocessorCount, dev);
    hipOccupancyMaxActiveBlocksPerMultiprocessor(&per_cu, k_mega, 256, 0);
    if (per_cu > 3) per_cu = 3;
    grid_blocks = cus * per_cu;
  }
  hipMemsetAsync(p.bar(), 0, XCD_BAR_WORDS * 4, stream);
  void* args[] = {&p};
  hipError_t e = hipLaunchCooperativeKernel((void*)k_mega, dim3(grid_blocks), dim3(256), args, 0, stream);
  if (e != hipSuccess) fprintf(stderr, "cooperative launch failed: %s (grid %d)\n", hipGetErrorString(e), grid_blocks);
#else
  k_ph<0><<<1024, 256, 0, stream>>>(p);
  k_ph<1><<<512, 256, 0, stream>>>(p);
  k_ph<2><<<512, 256, 0, stream>>>(p);
  k_ph<3><<<8, 256, 0, stream>>>(p);
  k_ph<4><<<512, 256, 0, stream>>>(p);
  k_ph<5><<<512, 256, 0, stream>>>(p);
  for (int b = 0; b < 8; ++b) { k_score<<<512, 256, 0, stream>>>(p, b); k_select<<<1024, 256, 0, stream>>>(p, b); }
  k_ph<22><<<1024, 256, 0, stream>>>(p);
  k_ph<23><<<512, 256, 0, stream>>>(p);
  k_ph<24><<<512, 256, 0, stream>>>(p);
  k_ph<25><<<1024, 256, 0, stream>>>(p);
#endif
}
```

```cpp
#include <hip/hip_runtime.h>
#include <hip/hip_cooperative_groups.h>
#include <stdint.h>
#include <stdio.h>
namespace cg = cooperative_groups;

#ifndef MEGA
#define MEGA 1
#endif
#ifndef REP_G1
#define REP_G1 1
#endif
#ifndef REP_SC
#define REP_SC 1
#endif
#ifndef REP_SEL
#define REP_SEL 1
#endif
#ifndef REP_ATT
#define REP_ATT 1
#endif
#ifndef REP_SSM
#define REP_SSM 1
#endif
#ifndef REP_G24
#define REP_G24 1
#endif
#ifndef REP_P0
#define REP_P0 1
#endif
#ifndef REP_S3
#define REP_S3 1
#endif
#ifndef REP_G3
#define REP_G3 1
#endif
#ifndef REP_G5
#define REP_G5 1
#endif

typedef _Float16 half_t;
typedef _Float16 half8 __attribute__((ext_vector_type(8)));
typedef _Float16 half4 __attribute__((ext_vector_type(4)));
typedef _Float16 half2v __attribute__((ext_vector_type(2)));
typedef float f32x16 __attribute__((ext_vector_type(16)));
typedef float f32x4 __attribute__((ext_vector_type(4)));
typedef unsigned int u32x4 __attribute__((ext_vector_type(4)));

constexpr int L = 16384, D = 2048, NIN = 8784, NP = 8832;
constexpr int C_Q = 0, C_K = 1024, C_V = 1280, C_AG = 1536, C_QI = 2560, C_KI = 3584, C_U = 3648,
              C_SG = 4160, C_MG = 4672, C_WI = 8768;
constexpr int SMEM_BYTES = 53248;
constexpr int BAND = 2048;
constexpr int NBAND = 5;
__device__ __host__ __forceinline__ constexpr int band_q0(int b) { return b == 0 ? 0 : b == 1 ? 5760 : b == 2 ? 9344 : b == 3 ? 12096 : b == 4 ? 14400 : 16384; }
__device__ __host__ __forceinline__ constexpr int band_rows(int b) { return band_q0(b + 1) - band_q0(b); }
__device__ __host__ __forceinline__ constexpr int band_stride(int b) { return band_q0(b + 1); }
constexpr int KP = 1024;
constexpr int NPHASE = 26;

constexpr size_t al256(size_t x) { return (x + 255) & ~(size_t)255; }
constexpr size_t OFF_proj = 0;
constexpr size_t OFF_kidx = OFF_proj + al256((size_t)L * NP * 2);
constexpr size_t OFF_h = OFF_kidx + al256((size_t)L * 64 * 2);
constexpr size_t OFF_wt_in = OFF_h + al256((size_t)L * D * 2);
constexpr size_t OFF_wt_att = OFF_wt_in + al256((size_t)NP * D * 2);
constexpr size_t OFF_wt_glu = OFF_wt_att + al256((size_t)2048 * 1024 * 2);
constexpr size_t OFF_wt_ssm = OFF_wt_glu + al256((size_t)512 * 512 * 2);
constexpr size_t OFF_wt_out = OFF_wt_ssm + al256((size_t)2048 * 512 * 2);
constexpr size_t OFF_s1 = OFF_wt_out + al256((size_t)2048 * 2048 * 2);
constexpr size_t OFF_sg = OFF_s1 + al256((size_t)L * 512 * 2);
constexpr size_t OFF_attg = OFF_sg + al256((size_t)L * 512 * 2);
constexpr size_t OFF_cmT = OFF_attg + al256((size_t)L * 1024 * 2);
constexpr size_t OFF_cos128 = OFF_cmT + al256((size_t)32 * 16 * 128 * 2);
constexpr size_t OFF_sin128 = OFF_cos128 + al256((size_t)L * 16 * 4);
constexpr size_t OFF_cos64 = OFF_sin128 + al256((size_t)L * 16 * 4);
constexpr size_t OFF_sin64 = OFF_cos64 + al256((size_t)L * 8 * 4);
constexpr size_t OFF_lam = OFF_sin64 + al256((size_t)L * 8 * 4);
constexpr size_t OFF_bb = OFF_lam + al256((size_t)2048 * 2 * 4);
constexpr size_t OFF_E = OFF_bb + al256((size_t)2048 * 32 * 4);
constexpr size_t OFF_sel = OFF_E + al256((size_t)256 * 2048 * 2 * 4);
constexpr size_t OFF_bar = OFF_sel + al256((size_t)L * 256 * 2);
constexpr size_t WS_NEEDED = OFF_bar + al256((size_t)3456 * 4);
struct Params {
  const float* x; const int* pos; const float* g_norm; const float* w_in; const float* b_merge;
  const float* a_re; const float* a_im; const float* log_dt; const float* b_re; const float* b_im;
  const float* c_re; const float* c_im; const float* ssm_d; const float* w_glu; const float* b_glu;
  const float* w_att_out; const float* w_ssm_out; const float* w_out; const float* g_final;
  float* out;
  char* ws;
  __device__ __host__ __forceinline__ half_t* proj() const { return (half_t*)(ws + OFF_proj); }
  __device__ __host__ __forceinline__ half_t* kidx() const { return (half_t*)(ws + OFF_kidx); }
  __device__ __host__ __forceinline__ half_t* h() const { return (half_t*)(ws + OFF_h); }
  __device__ __host__ __forceinline__ half_t* wt_in() const { return (half_t*)(ws + OFF_wt_in); }
  __device__ __host__ __forceinline__ half_t* wt_att() const { return (half_t*)(ws + OFF_wt_att); }
  __device__ __host__ __forceinline__ half_t* wt_glu() const { return (half_t*)(ws + OFF_wt_glu); }
  __device__ __host__ __forceinline__ half_t* wt_ssm() const { return (half_t*)(ws + OFF_wt_ssm); }
  __device__ __host__ __forceinline__ half_t* wt_out() const { return (half_t*)(ws + OFF_wt_out); }
  __device__ __host__ __forceinline__ half_t* s1() const { return (half_t*)(ws + OFF_s1); }
  __device__ __host__ __forceinline__ half_t* sg() const { return (half_t*)(ws + OFF_sg); }
  __device__ __host__ __forceinline__ half_t* attg() const { return (half_t*)(ws + OFF_attg); }
  __device__ __host__ __forceinline__ half_t* cmT() const { return (half_t*)(ws + OFF_cmT); }
  __device__ __host__ __forceinline__ float* cos128() const { return (float*)(ws + OFF_cos128); }
  __device__ __host__ __forceinline__ float* sin128() const { return (float*)(ws + OFF_sin128); }
  __device__ __host__ __forceinline__ float* cos64() const { return (float*)(ws + OFF_cos64); }
  __device__ __host__ __forceinline__ float* sin64() const { return (float*)(ws + OFF_sin64); }
  __device__ __host__ __forceinline__ float* lam() const { return (float*)(ws + OFF_lam); }
  __device__ __host__ __forceinline__ float* bb() const { return (float*)(ws + OFF_bb); }
  __device__ __host__ __forceinline__ float* E() const { return (float*)(ws + OFF_E); }
  __device__ __host__ __forceinline__ unsigned short* sel() const { return (unsigned short*)(ws + OFF_sel); }
  __device__ __host__ __forceinline__ unsigned* bar() const { return (unsigned*)(ws + OFF_bar); }
};


#define XB_TMO      128
#define XB_XCNT(j)  (256  + 64 * (j))
#define XB_XSUB(j)  (1280 + 64 * (j))
#define XB_XGEN(j)  (2304 + 64 * (j))
#define XB_TOP      3328
#define XB_TOPGEN   3392
#define XCD_BAR_WORDS 3456
#define XB_SPIN_CAP (1u << 18)
#define LAS __attribute__((address_space(3)))

__device__ __forceinline__ unsigned xb_ld(unsigned* p)              { return __hip_atomic_load(p, __ATOMIC_RELAXED, __HIP_MEMORY_SCOPE_AGENT); }
__device__ __forceinline__ unsigned xb_add(unsigned* p, unsigned v) { return __hip_atomic_fetch_add(p, v, __ATOMIC_RELAXED, __HIP_MEMORY_SCOPE_AGENT); }
__device__ __forceinline__ unsigned xb_xcc_id() { return (unsigned)__builtin_amdgcn_s_getreg((3 << 11) | 20) & 0xFu; }
#define XB_SPIN(cond, bar) do { unsigned _sp = 0; while (cond) { __builtin_amdgcn_s_sleep(1); \
    if ((++_sp & 255u) == 0u) { if (xb_ld(&(bar)[XB_TMO])) break; if (_sp > XB_SPIN_CAP) { atomicAdd(&(bar)[XB_TMO], 1u); break; } } } } while (0)

struct XcdBarrier { unsigned* bar; unsigned x; volatile LAS unsigned* st; };

__device__ __forceinline__ XcdBarrier xcd_barrier_post(unsigned* bar, volatile LAS unsigned* st) {
    XcdBarrier b; b.bar = bar; b.x = xb_xcc_id(); b.st = st;
    if (threadIdx.x == 0) (void)xb_add(&bar[XB_XCNT(b.x)], 1u);
    return b;
}
__device__ __forceinline__ void xcd_barrier_complete(unsigned* bar, unsigned x, unsigned& nloc, unsigned& nx) {
    const unsigned G = gridDim.x * gridDim.y * gridDim.z;
    unsigned sum, cnt, mine, sp = 0u;
    for (;;) {
        sum = 0u; cnt = 0u; mine = 0u;
#pragma unroll
        for (unsigned j = 0; j < 16; ++j) { const unsigned c = xb_ld(&bar[XB_XCNT(j)]); sum += c; cnt += (c > 0u) ? 1u : 0u; mine = (j == x) ? c : mine; }
        if (sum == G) break;
        __builtin_amdgcn_s_sleep(1);
        if ((++sp & 255u) == 0u) { if (xb_ld(&bar[XB_TMO])) break; if (sp > XB_SPIN_CAP) { atomicAdd(&bar[XB_TMO], 1u); break; } }
    }
    nloc = mine > 0u ? mine : 1u; nx = cnt > 0u ? cnt : 1u;
}
__device__ __forceinline__ void xcd_barrier(const XcdBarrier& b) {
    asm volatile("s_waitcnt vmcnt(0)" ::: "memory");
    __syncthreads();
    if (threadIdx.x == 0) {
        unsigned* bar = b.bar;
        __builtin_amdgcn_s_waitcnt(0);
        unsigned nloc = b.st[0], nx = b.st[1];
        if (nloc == 0u) { xcd_barrier_complete(bar, b.x, nloc, nx); b.st[0] = nloc; b.st[1] = nx; }
        const unsigned old = xb_add(&bar[XB_XSUB(b.x)], 1u);
        const unsigned gen = old / nloc;
        if (old + 1u == (gen + 1u) * nloc) {
            __builtin_amdgcn_fence(__ATOMIC_RELEASE, "agent");
            asm volatile("s_waitcnt vmcnt(0)" ::: "memory");
            const unsigned og = xb_add(&bar[XB_TOP], 1u);
            const unsigned tg = og / nx;
            if (og + 1u == (tg + 1u) * nx) xb_add(&bar[XB_TOPGEN], 1u);
            else XB_SPIN(xb_ld(&bar[XB_TOPGEN]) == tg, bar);
            __builtin_amdgcn_fence(__ATOMIC_ACQUIRE, "agent");
            xb_add(&bar[XB_XGEN(b.x)], 1u);
            asm volatile("s_waitcnt vmcnt(0)" ::: "memory");
        } else {
            XB_SPIN(xb_ld(&bar[XB_XGEN(b.x)]) == gen, bar);
            __builtin_amdgcn_fence(__ATOMIC_ACQUIRE, "agent");
            asm volatile("s_waitcnt vmcnt(0)" ::: "memory");
        }
    }
    __syncthreads();
}

__device__ __forceinline__ int fresh_tid() { int t = threadIdx.x; asm volatile("" : "+v"(t)); return t; }
__device__ __forceinline__ float wave_sum(float v) {
#pragma unroll
  for (int o = 32; o > 0; o >>= 1) v += __shfl_xor(v, o, 64);
  return v;
}
__device__ __forceinline__ float sigmoidf_(float x) { return 1.0f / (1.0f + __expf(-x)); }
__device__ __forceinline__ float siluf_(float x) { return x / (1.0f + __expf(-x)); }
__device__ __forceinline__ float gelu_tanh(float x) {
  float u = 0.7978845608028654f * (x + 0.044715f * x * x * x);
  float t = 1.0f - 2.0f / (__expf(2.0f * u) + 1.0f);
  return 0.5f * x * (1.0f + t);
}

constexpr int T0_NORM = L / 4;
constexpr int T0_WIN = (D / 64) * (NP / 64);
constexpr int T0_WATT = (1024 / 64) * (2048 / 64);
constexpr int T0_WGLU = (512 / 64) * (512 / 64);
constexpr int T0_WSSM = (512 / 64) * (2048 / 64);
constexpr int T0_WOUT = (2048 / 64) * (2048 / 64);
constexpr int T0_ROT = (L * 24) / 256;
constexpr int T0_SSM = 8;
constexpr int T0_TOTAL = T0_NORM + T0_WIN + T0_WATT + T0_WGLU + T0_WSSM + T0_WOUT + T0_ROT + T0_SSM;

__device__ __forceinline__ int remap_col(int np) {
  if (np < 3648) return np;
  if (np < 8768) return np + 16;
  if (np < 8784) return np - 8768 + 3648;
  return -1;
}

__device__ __forceinline__ void transpose_tile(const float* __restrict__ W, int K, int N, half_t* __restrict__ Wt,
                               int kt, int nt, bool remap, char* smem) {
  half_t* t = (half_t*)smem;
  const int tid = fresh_tid();
  {
    const int nn = tid & 63;
    const int np = nt * 64 + nn;
    const int n = remap ? remap_col(np) : np;
    const int nc = n >= 0 ? n : 0;
    float wv[16];
#pragma unroll
    for (int i = 0; i < 16; ++i) wv[i] = W[(size_t)(kt * 64 + (tid >> 6) + 4 * i) * N + nc];
    asm volatile("" ::: "memory");
#pragma unroll
    for (int i = 0; i < 16; ++i) t[nn * 66 + (tid >> 6) + 4 * i] = (half_t)(n >= 0 ? wv[i] : 0.0f);
  }
  __syncthreads();
#pragma unroll 4
  for (int i = 0; i < 8; ++i) {
    int e = tid + 256 * i;
    int nn = e >> 5, kp = e & 31;
    half2v v; v.x = t[nn * 66 + kp * 2]; v.y = t[nn * 66 + kp * 2 + 1];
    *(half2v*)(Wt + (size_t)(nt * 64 + nn) * K + kt * 64 + kp * 2) = v;
  }
  __syncthreads();
}

__device__ __forceinline__ void prep_task(const Params& P, int t, char* smem) {
  const int tid = fresh_tid(), lane = tid & 63, wave = tid >> 6;
  if (t < T0_NORM) {
    int row = t * 4 + wave;
    const float4* xr = (const float4*)(P.x + (size_t)row * D);
    float4 v[8]; float ss = 0.f;
#pragma unroll
    for (int j = 0; j < 8; ++j) { v[j] = xr[j * 64 + lane]; ss += v[j].x * v[j].x + v[j].y * v[j].y + v[j].z * v[j].z + v[j].w * v[j].w; }
    ss = wave_sum(ss);
    float sc = rsqrtf(ss * (1.0f / D) + 1e-6f);
    const float4* g4 = (const float4*)P.g_norm;
#pragma unroll
    for (int j = 0; j < 8; ++j) {
      float4 g = g4[j * 64 + lane];
      half4 o; o.x = (half_t)(v[j].x * sc * g.x); o.y = (half_t)(v[j].y * sc * g.y);
      o.z = (half_t)(v[j].z * sc * g.z); o.w = (half_t)(v[j].w * sc * g.w);
      *(half4*)(P.h() + (size_t)row * D + (j * 64 + lane) * 4) = o;
    }
    return;
  }
  t -= T0_NORM;
  if (t < T0_WIN) { transpose_tile(P.w_in, D, NIN, P.wt_in(), t % 32, t / 32, true, smem); return; }
  t -= T0_WIN;
  if (t < T0_WATT) { transpose_tile(P.w_att_out, 1024, 2048, P.wt_att(), t % 16, t / 16, false, smem); return; }
  t -= T0_WATT;
  if (t < T0_WGLU) { transpose_tile(P.w_glu, 512, 512, P.wt_glu(), t % 8, t / 8, false, smem); return; }
  t -= T0_WGLU;
  if (t < T0_WSSM) { transpose_tile(P.w_ssm_out, 512, 2048, P.wt_ssm(), t % 8, t / 8, false, smem); return; }
  t -= T0_WSSM;
  if (t < T0_WOUT) { transpose_tile(P.w_out, 2048, 2048, P.wt_out(), t % 32, t / 32, false, smem); return; }
  t -= T0_WOUT;
  if (t < T0_ROT) {
    int e = t * 256 + tid;
    int tok = e / 24, i = e % 24;
    float a;
    if (i < 16) { a = (-13.122363377404328f) * (float)i; a = a * (2.0f / 32.0f); }
    else        { a = (-13.122363377404328f) * (float)(i - 16); a = a * (2.0f / 16.0f); }
    float inv = expf(a);
    float ang = (float)P.pos[tok] * inv;
    double rev = (double)ang * 0.15915494309189535;
    rev = rev - rint(rev);
    float fr = (float)rev;
    float s = __builtin_amdgcn_sinf(fr);
    float c = __builtin_amdgcn_cosf(fr);
    if (i < 16) { P.cos128()[tok * 16 + i] = c; P.sin128()[tok * 16 + i] = s; }
    else        { P.cos64()[tok * 8 + i - 16] = c; P.sin64()[tok * 8 + i - 16] = s; }
    return;
  }
  t -= T0_ROT;
  {
    int gp = t * 256 + tid;
    int g = gp >> 6, p = gp & 63;
    float dt = expf(P.log_dt[g]);
    float ar = P.a_re[gp], ai = P.a_im[gp];
    float mag = expf(ar * dt);
    float ang = ai * dt;
    double rev = (double)ang * 0.15915494309189535;
    rev = rev - rint(rev);
    float fr = (float)rev;
    float lr = mag * __builtin_amdgcn_cosf(fr);
    float li = mag * __builtin_amdgcn_sinf(fr);
    float den = ar * ar + ai * ai;
    float cr = ((lr - 1.0f) * ar + li * ai) / den;
    float ci = (li * ar - (lr - 1.0f) * ai) / den;
    P.lam()[gp * 2] = lr; P.lam()[gp * 2 + 1] = li;
    for (int c = 0; c < 16; ++c) {
      float br = P.b_re[gp * 16 + c], bi = P.b_im[gp * 16 + c];
      P.bb()[gp * 32 + c] = cr * br - ci * bi;
      P.bb()[gp * 32 + 16 + c] = cr * bi + ci * br;
      P.cmT()[(g * 16 + c) * 128 + p] = (half_t)P.c_re[(g * 16 + c) * 64 + p];
      P.cmT()[(g * 16 + c) * 128 + 64 + p] = (half_t)(-P.c_im[(g * 16 + c) * 64 + p]);
    }
  }
}

constexpr int LDS_ROW = 144;
constexpr int LDS_TILE = 128 * LDS_ROW;
constexpr int LDS_STAGE = 2 * LDS_TILE;

__device__ __forceinline__ void gemm_loop(const half_t* __restrict__ A, int lda, const half_t* __restrict__ B,
                                          int ldb, int K, int m0, int n0, f32x16 (&acc)[2][2], char* smem) {
  const int tid = fresh_tid(), lane = tid & 63, wave = tid >> 6;
  const int wm = wave >> 1, wn = wave & 1;
  const int lrow = tid >> 3, lkc = tid & 7;
  const half_t* ga = A + (size_t)(m0 + lrow) * lda + lkc * 8;
  const half_t* gb = B + (size_t)(n0 + lrow) * ldb + lkc * 8;
  u32x4 ra[4], rb[4];
  const int KT = K >> 6;
#pragma unroll
  for (int i = 0; i < 4; ++i) {
    ra[i] = *(const u32x4*)(ga + (size_t)(32 * i) * lda);
    rb[i] = *(const u32x4*)(gb + (size_t)(32 * i) * ldb);
  }
  const int arow = (wm * 64 + (lane & 31)) * LDS_ROW + (lane >> 5) * 16;
  const int brow = LDS_TILE + (wn * 64 + (lane & 31)) * LDS_ROW + (lane >> 5) * 16;
  for (int kt = 0; kt < KT; ++kt) {
    __syncthreads();
#pragma unroll
    for (int i = 0; i < 4; ++i) {
      *(u32x4*)(smem + (lrow + 32 * i) * LDS_ROW + lkc * 16) = ra[i];
      *(u32x4*)(smem + LDS_TILE + (lrow + 32 * i) * LDS_ROW + lkc * 16) = rb[i];
    }
    {
      const int kn = (kt + 1 < KT) ? kt + 1 : kt;
#pragma unroll
      for (int i = 0; i < 4; ++i) {
        ra[i] = *(const u32x4*)(ga + (size_t)(32 * i) * lda + kn * 64);
        rb[i] = *(const u32x4*)(gb + (size_t)(32 * i) * ldb + kn * 64);
      }
    }
    __syncthreads();
#pragma unroll
    for (int ks = 0; ks < 4; ++ks) {
      half8 a0 = *(const half8*)(smem + arow + ks * 32);
      half8 a1 = *(const half8*)(smem + arow + 32 * LDS_ROW + ks * 32);
      half8 b0 = *(const half8*)(smem + brow + ks * 32);
      half8 b1 = *(const half8*)(smem + brow + 32 * LDS_ROW + ks * 32);
      acc[0][0] = __builtin_amdgcn_mfma_f32_32x32x16_f16(a0, b0, acc[0][0], 0, 0, 0);
      acc[0][1] = __builtin_amdgcn_mfma_f32_32x32x16_f16(a0, b1, acc[0][1], 0, 0, 0);
      acc[1][0] = __builtin_amdgcn_mfma_f32_32x32x16_f16(a1, b0, acc[1][0], 0, 0, 0);
      acc[1][1] = __builtin_amdgcn_mfma_f32_32x32x16_f16(a1, b1, acc[1][1], 0, 0, 0);
      if (ks & 1) asm volatile("" ::: "memory");
    }
  }
  __builtin_amdgcn_sched_barrier(0);
  __syncthreads();
  __builtin_amdgcn_sched_barrier(0);
}

#define ACC_ROW(mt, i) (wm * 64 + (mt) * 32 + ((i) & 3) + 8 * ((i) >> 2) + 4 * (lane >> 5))
#define ACC_COL(nt) (wn * 64 + (nt) * 32 + (lane & 31))

constexpr int CS_STRIDE = 136;

__device__ __forceinline__ void tile_coords(int t, int NT, int& mt, int& nt) {
  int per = 16 * NT;
  int grp = t / per, r = t - grp * per;
  nt = r >> 4; mt = grp * 16 + (r & 15);
}

__device__ __forceinline__ void g1_tile(const Params& P, int mt, int nt, char* smem) {
  const int tid = fresh_tid(), lane = tid & 63, wave = tid >> 6;
  const int wm = wave >> 1, wn = wave & 1;
  const int m0 = mt * 128, n0 = nt * 128;
  f32x16 acc[2][2];
#pragma unroll
  for (int a = 0; a < 2; ++a)
#pragma unroll
    for (int b = 0; b < 2; ++b)
#pragma unroll
      for (int i = 0; i < 16; ++i) acc[a][b][i] = 0.f;
  gemm_loop(P.h(), D, P.wt_in(), D, D, m0, n0, acc, smem);
  half_t* cs = (half_t*)smem;
  half_t* csw = cs + (wm * 64 + 4 * (lane >> 5)) * CS_STRIDE + wn * 64 + (lane & 31);
#pragma unroll
  for (int a = 0; a < 2; ++a)
#pragma unroll
    for (int b = 0; b < 2; ++b) {
      const float sc = (n0 + ACC_COL(b) >= C_WI) ? (1.0f / 32.0f) : 1.0f;
#pragma unroll
      for (int i = 0; i < 16; ++i) csw[(a * 32 + (i & 3) + 8 * (i >> 2)) * CS_STRIDE + b * 32] = (half_t)(acc[a][b][i] * sc);
    }
  __syncthreads();
#pragma unroll 2
  for (int i = 0; i < 8; ++i) {
    int c = tid + 256 * i;
    int row = c >> 4, cc = (c & 15) * 8;
    int n = n0 + cc, m = m0 + row;
    half8 v = *(const half8*)(cs + row * CS_STRIDE + cc);
    if (n < C_V) {
      int d = n & 127;
      if (d < 32) {
        const bool lo = d < 16;
        half8 o = *(const half8*)(cs + row * CS_STRIDE + (lo ? cc + 16 : cc - 16));
        const int fi = lo ? d : d - 16;
        const float* cp = P.cos128() + (size_t)m * 16 + fi;
        const float* sp = P.sin128() + (size_t)m * 16 + fi;
        half8 r;
#pragma unroll
        for (int j = 0; j < 8; ++j) {
          float cv = cp[j], sv = sp[j];
          float x1 = lo ? (float)v[j] : (float)o[j];
          float x2 = lo ? (float)o[j] : (float)v[j];
          r[j] = (half_t)(lo ? (x1 * cv - x2 * sv) : (x2 * cv + x1 * sv));
        }
        v = r;
      }
    } else if (n >= C_QI && n < C_U) {
      int d = n & 63;
      if (d < 16) {
        const bool lo = d < 8;
        half8 o = *(const half8*)(cs + row * CS_STRIDE + (lo ? cc + 8 : cc - 8));
        const float* cp = P.cos64() + (size_t)m * 8;
        const float* sp = P.sin64() + (size_t)m * 8;
        half8 r;
#pragma unroll
        for (int j = 0; j < 8; ++j) {
          float cv = cp[j], sv = sp[j];
          float x1 = lo ? (float)v[j] : (float)o[j];
          float x2 = lo ? (float)o[j] : (float)v[j];
          r[j] = (half_t)(lo ? (x1 * cv - x2 * sv) : (x2 * cv + x1 * sv));
        }
        v = r;
      }
    }
    if (n >= C_KI && n < C_U) *(half8*)(P.kidx() + (size_t)m * 64 + (n - C_KI)) = v;
    else *(half8*)(P.proj() + (size_t)m * NP + n) = v;
  }
}

__device__ __forceinline__ void g3_tile(const Params& P, int mt, int nt, char* smem) {
  const int tid = fresh_tid(), lane = tid & 63, wave = tid >> 6;
  const int wm = wave >> 1, wn = wave & 1;
  const int m0 = mt * 128, n0 = nt * 128;
  f32x16 acc[2][2];
#pragma unroll
  for (int a = 0; a < 2; ++a)
#pragma unroll
    for (int b = 0; b < 2; ++b)
#pragma unroll
      for (int i = 0; i < 16; ++i) acc[a][b][i] = 0.f;
  gemm_loop(P.s1(), 512, P.wt_glu(), 512, 512, m0, n0, acc, smem);
  half_t* cs = (half_t*)smem;
  half_t* csw = cs + (wm * 64 + 4 * (lane >> 5)) * CS_STRIDE + wn * 64 + (lane & 31);
#pragma unroll
  for (int a = 0; a < 2; ++a)
#pragma unroll
    for (int b = 0; b < 2; ++b) {
      const int col = ACC_COL(b);
      const int n = n0 + col;
      const float bg = P.b_glu[n];
#pragma unroll
      for (int i0 = 0; i0 < 16; i0 += 8) {
        half_t s1h[8], gth[8];
#pragma unroll
        for (int i = 0; i < 8; ++i) {
          const size_t m = m0 + ACC_ROW(a, i0 + i);
          s1h[i] = P.s1()[m * 512 + n];
          gth[i] = P.proj()[m * NP + C_SG + n];
        }
        asm volatile("" ::: "memory");
#pragma unroll
        for (int i = 0; i < 8; ++i) {
          float v = (float)s1h[i] * sigmoidf_(acc[a][b][i0 + i] + bg) * siluf_((float)gth[i]);
          csw[(a * 32 + ((i0 + i) & 3) + 8 * ((i0 + i) >> 2)) * CS_STRIDE + b * 32] = (half_t)v;
        }
      }
    }
  __syncthreads();
#pragma unroll 2
  for (int i = 0; i < 8; ++i) {
    int c = tid + 256 * i;
    int row = c >> 4, cc = (c & 15) * 8;
    *(half8*)(P.sg() + (size_t)(m0 + row) * 512 + n0 + cc) = *(const half8*)(cs + row * CS_STRIDE + cc);
  }
}

template <int WHICH>
__device__ __forceinline__ void g24_tile(const Params& P, int mt, int nt, char* smem) {
  const int tid = fresh_tid(), lane = tid & 63, wave = tid >> 6;
  const int wm = wave >> 1, wn = wave & 1;
  const int m0 = mt * 128, n0 = nt * 128;
  f32x16 acc[2][2];
#pragma unroll
  for (int a = 0; a < 2; ++a)
#pragma unroll
    for (int b = 0; b < 2; ++b)
#pragma unroll
      for (int i = 0; i < 16; ++i) acc[a][b][i] = 0.f;
  if (WHICH == 0) gemm_loop(P.attg(), 1024, P.wt_att(), 1024, 1024, m0, n0, acc, smem);
  else            gemm_loop(P.sg(), 512, P.wt_ssm(), 512, 512, m0, n0, acc, smem);
  half_t* cs = (half_t*)smem;
#pragma unroll 1
  for (int i = 0; i < 8; ++i) {
    const int c = tid + 256 * i;
    const int row = c >> 4, cc = (c & 15) * 8;
    const half8 gv = *(const half8*)(P.proj() + (size_t)(m0 + row) * NP + C_MG + WHICH * 2048 + n0 + cc);
    const f32x4 ba = *(const f32x4*)(P.b_merge + WHICH * 2048 + n0 + cc), bb4 = *(const f32x4*)(P.b_merge + WHICH * 2048 + n0 + cc + 4);
    asm volatile("" ::: "memory");
    half8 r;
#pragma unroll
    for (int j = 0; j < 8; ++j) r[j] = (half_t)sigmoidf_((float)gv[j] + (j < 4 ? ba[j & 3] : bb4[j & 3]));
    *(half8*)(cs + row * CS_STRIDE + cc) = r;
  }
  __syncthreads();
  half_t* csw = cs + (wm * 64 + 4 * (lane >> 5)) * CS_STRIDE + wn * 64 + (lane & 31);
#pragma unroll
  for (int a = 0; a < 2; ++a)
#pragma unroll
    for (int b = 0; b < 2; ++b) {
#pragma unroll
      for (int i = 0; i < 16; ++i) {
        const int o = (a * 32 + (i & 3) + 8 * (i >> 2)) * CS_STRIDE + b * 32;
        csw[o] = (half_t)(acc[a][b][i] * (float)csw[o]);
      }
      asm volatile("" ::: "memory");
    }
  __syncthreads();
  half_t* mixed = P.h();
#pragma unroll 2
  for (int i = 0; i < 8; ++i) {
    int c = tid + 256 * i;
    int row = c >> 4, cc = (c & 15) * 8;
    half8 v = *(const half8*)(cs + row * CS_STRIDE + cc);
    half_t* dst = mixed + (size_t)(m0 + row) * D + n0 + cc;
    if (WHICH == 1) {
      const half8 pv = *(const half8*)dst;
#pragma unroll
      for (int j = 0; j < 8; ++j) v[j] = (half_t)((float)v[j] + (float)pv[j]);
    }
    *(half8*)dst = v;
  }
}

__device__ __forceinline__ void g5_tile(const Params& P, int mt, int nt, char* smem) {
  const int tid = fresh_tid(), lane = tid & 63, wave = tid >> 6;
  const int wm = wave >> 1, wn = wave & 1;
  const int m0 = mt * 128, n0 = nt * 128;
  f32x16 acc[2][2];
#pragma unroll
  for (int a = 0; a < 2; ++a)
#pragma unroll
    for (int b = 0; b < 2; ++b)
#pragma unroll
      for (int i = 0; i < 16; ++i) acc[a][b][i] = 0.f;
  gemm_loop(P.h(), D, P.wt_out(), D, D, m0, n0, acc, smem);
#pragma unroll
  for (int a = 0; a < 2; ++a)
#pragma unroll
    for (int b = 0; b < 2; ++b) {
      const int n = n0 + ACC_COL(b);
      float xv[16];
#pragma unroll
      for (int i = 0; i < 16; ++i) xv[i] = P.x[(size_t)(m0 + ACC_ROW(a, i)) * D + n];
      asm volatile("" ::: "memory");
#pragma unroll
      for (int i = 0; i < 16; ++i) P.out[(size_t)(m0 + ACC_ROW(a, i)) * D + n] = xv[i] + acc[a][b][i];
    }
}

__device__ __forceinline__ void fn_task(const Params& P, int t) {
  const int tid = fresh_tid(), lane = tid & 63, wave = tid >> 6;
  int row = t * 4 + wave;
  float4* xr = (float4*)(P.out + (size_t)row * D);
  float4 v[8]; float ss = 0.f;
#pragma unroll
  for (int j = 0; j < 8; ++j) { v[j] = xr[j * 64 + lane]; ss += v[j].x * v[j].x + v[j].y * v[j].y + v[j].z * v[j].z + v[j].w * v[j].w; }
  ss = wave_sum(ss);
  float sc = rsqrtf(ss * (1.0f / D) + 1e-6f);
  const float4* g4 = (const float4*)P.g_final;
#pragma unroll
  for (int j = 0; j < 8; ++j) {
    float4 g = g4[j * 64 + lane];
    float4 o; o.x = v[j].x * sc * g.x; o.y = v[j].y * sc * g.y; o.z = v[j].z * sc * g.z; o.w = v[j].w * sc * g.w;
    xr[j * 64 + lane] = o;
  }
}

__device__ __forceinline__ void ssm_local(const Params& P, int item, char* smem, bool final_pass) {
  const int tid = fresh_tid(), lane = tid & 63, wave = tid >> 6;
  const int it = item * 4 + wave;
  const int n = it >> 5, g = it & 31;
  half_t* ub = (half_t*)(smem + wave * 2048);
  half_t* xs = (half_t*)(smem + 8192 + wave * 8192);
  __syncthreads();
  {
    const u32x4* src = (const u32x4*)(P.proj() + (size_t)(n * 64 + lane) * NP + C_U + g * 16);
    u32x4 u0 = src[0], u1 = src[1];
    *(u32x4*)(ub + lane * 16) = u0;
    *(u32x4*)(ub + lane * 16 + 8) = u1;
  }
  const int gp = g * 64 + lane;
  float bre[16], bim[16];
  {
    const float4* b4 = (const float4*)(P.bb() + (size_t)gp * 32);
#pragma unroll
    for (int j = 0; j < 4; ++j) { float4 v = b4[j]; bre[4 * j] = v.x; bre[4 * j + 1] = v.y; bre[4 * j + 2] = v.z; bre[4 * j + 3] = v.w; }
#pragma unroll
    for (int j = 0; j < 4; ++j) { float4 v = b4[4 + j]; bim[4 * j] = v.x; bim[4 * j + 1] = v.y; bim[4 * j + 2] = v.z; bim[4 * j + 3] = v.w; }
  }
  const float lr = P.lam()[gp * 2], li = P.lam()[gp * 2 + 1];
  float xr = 0.f, xi = 0.f;
  if (final_pass) { xr = P.E()[((size_t)n * 2048 + gp) * 2]; xi = P.E()[((size_t)n * 2048 + gp) * 2 + 1]; }
  __syncthreads();
  half8 bf[4];
  float dsk = 0.f;
  if (final_pass) {
#pragma unroll
    for (int ks = 0; ks < 4; ++ks)
      bf[ks] = *(const half8*)(P.cmT() + (size_t)(g * 16 + (lane & 15)) * 128 + ks * 32 + (lane >> 4) * 8);
    dsk = P.ssm_d[g * 16 + (lane & 15)];
  }
#pragma unroll 1
  for (int hb = 0; hb < 2; ++hb) {
#pragma unroll 2
    for (int tl = 0; tl < 32; ++tl) {
      const int tk = hb * 32 + tl;
      half8 ua = *(const half8*)(ub + tk * 16);
      half8 uc = *(const half8*)(ub + tk * 16 + 8);
      float br = 0.f, bi = 0.f;
#pragma unroll
      for (int c = 0; c < 8; ++c) { float uv = (float)ua[c]; br += bre[c] * uv; bi += bim[c] * uv; }
#pragma unroll
      for (int c = 0; c < 8; ++c) { float uv = (float)uc[c]; br += bre[8 + c] * uv; bi += bim[8 + c] * uv; }
      float nr = lr * xr - li * xi + br;
      float ni = lr * xi + li * xr + bi;
      xr = nr; xi = ni;
      if (final_pass) {
        xs[tl * 128 + lane] = (half_t)xr;
        xs[tl * 128 + 64 + lane] = (half_t)xi;
      }
    }
    if (final_pass) {
#pragma unroll
      for (int rt = 0; rt < 2; ++rt) {
        f32x4 y = {0.f, 0.f, 0.f, 0.f};
#pragma unroll
        for (int ks = 0; ks < 4; ++ks) {
          half8 af = *(const half8*)(xs + (rt * 16 + (lane & 15)) * 128 + ks * 32 + (lane >> 4) * 8);
          y = __builtin_amdgcn_mfma_f32_16x16x32_f16(af, bf[ks], y, 0, 0, 0);
        }
#pragma unroll
        for (int i = 0; i < 4; ++i) {
          int tk = hb * 32 + rt * 16 + (lane >> 4) * 4 + i;
          float uv = (float)ub[tk * 16 + (lane & 15)];
          float yv = y[i] + dsk * uv;
          P.s1()[(size_t)(n * 64 + tk) * 512 + g * 16 + (lane & 15)] = (half_t)gelu_tanh(yv);
        }
      }
    }
  }
  if (!final_pass) {
    P.E()[((size_t)n * 2048 + gp) * 2] = xr;
    P.E()[((size_t)n * 2048 + gp) * 2 + 1] = xi;
  }
}

__device__ __forceinline__ void ssm_carry(const Params& P, int blk) {
  const int gp = blk * 256 + fresh_tid();
  float lr = P.lam()[gp * 2], li = P.lam()[gp * 2 + 1];
#pragma unroll
  for (int s = 0; s < 6; ++s) { float nr = lr * lr - li * li; float ni = 2.0f * lr * li; lr = nr; li = ni; }
  float sr = 0.f, si = 0.f;
  float2* Ep = (float2*)P.E();
  for (int n0 = 0; n0 < 256; n0 += 32) {
    float2 e[32];
#pragma unroll
    for (int u = 0; u < 32; ++u) e[u] = Ep[(size_t)(n0 + u) * 2048 + gp];
    asm volatile("" ::: "memory");
#pragma unroll
    for (int u = 0; u < 32; ++u) {
      Ep[(size_t)(n0 + u) * 2048 + gp] = make_float2(sr, si);
      float nr = lr * sr - li * si + e[u].x;
      float ni = lr * si + li * sr + e[u].y;
      sr = nr; si = ni;
    }
  }
}

constexpr int QROW = 2080;

__device__ __forceinline__ void idx_score_item(const Params& P, int band, int item, char* smem) {
  const int tid = fresh_tid(), lane = tid & 63, wave = tid >> 6;
  const int nqt = band_rows(band) >> 4;
  const int qt = item % nqt, piece = item / nqt;
  const int q0 = band_q0(band) + qt * 16;
  const int sstride = band_stride(band);
  const int nadm = 64 * ((q0 >> 6) + 1);
  const int k0 = piece * KP;
  if (k0 >= nadm) return;
  const int kend = min(k0 + KP, nadm);
  __syncthreads();
  {
    u32x4 qv[8];
#pragma unroll
    for (int i = 0; i < 8; ++i) {
      const int c = tid + 256 * i;
      qv[i] = *(const u32x4*)(P.proj() + (size_t)(q0 + (c >> 7)) * NP + C_QI + (c & 127) * 8);
    }
    asm volatile("" ::: "memory");
#pragma unroll
    for (int i = 0; i < 8; ++i) {
      const int c = tid + 256 * i;
      *(u32x4*)(smem + (c >> 7) * QROW + (c & 127) * 16) = qv[i];
    }
  }
  float* wl = (float*)(smem + 16 * QROW);
  if (tid < 32) {
    const half8 wv = *(const half8*)(P.proj() + (size_t)(q0 + (tid & 15)) * NP + C_WI + (tid >> 4) * 8);
#pragma unroll
    for (int j = 0; j < 8; ++j) wl[((tid >> 4) * 8 + j) * 16 + (tid & 15)] = (float)wv[j];
  }
  __syncthreads();
  float* S = P.out;
  const char* qbase = smem + (lane & 15) * QROW + (lane >> 4) * 16;
  for (int slab = k0 + wave * 64; slab < kend; slab += 256) {
    half8 kf[4][2];
#pragma unroll
    for (int st = 0; st < 4; ++st)
#pragma unroll
      for (int ks = 0; ks < 2; ++ks)
        kf[st][ks] = *(const half8*)(P.kidx() + (size_t)(slab + st * 16 + (lane & 15)) * 64 + ks * 32 + (lane >> 4) * 8);
    f32x4 acc[4];
#pragma unroll
    for (int st = 0; st < 4; ++st) acc[st] = f32x4{0.f, 0.f, 0.f, 0.f};
#pragma unroll 2
    for (int h = 0; h < 16; ++h) {
      const float wh = wl[h * 16 + (lane & 15)];
      const half8 q0f = *(const half8*)(qbase + h * 128);
      const half8 q1f = *(const half8*)(qbase + h * 128 + 64);
      f32x4 lg[4];
#pragma unroll
      for (int st = 0; st < 4; ++st) {
        lg[st] = f32x4{0.f, 0.f, 0.f, 0.f};
        lg[st] = __builtin_amdgcn_mfma_f32_16x16x32_f16(kf[st][0], q0f, lg[st], 0, 0, 0);
        lg[st] = __builtin_amdgcn_mfma_f32_16x16x32_f16(kf[st][1], q1f, lg[st], 0, 0, 0);
      }
#pragma unroll
      for (int st = 0; st < 4; ++st)
#pragma unroll
        for (int i = 0; i < 4; ++i) {
          float rl = __int_as_float(max(__float_as_int(lg[st][i]), 0));
          asm("" : "+v"(rl));
          acc[st][i] = __builtin_fmaf(rl, wh, acc[st][i]);
        }
    }
    float* srow = S + (size_t)(qt * 16 + (lane & 15)) * sstride + slab + 4 * (lane >> 4);
#pragma unroll
    for (int st = 0; st < 4; ++st) *(f32x4*)(srow + st * 16) = acc[st];
  }
}

__device__ __forceinline__ unsigned mono_key(float f) {
  unsigned u = __float_as_uint(f);
  return (u & 0x80000000u) ? ~u : (u | 0x80000000u);
}

__device__ __forceinline__ int wave_scan_add_i(int v) {
  v += __builtin_amdgcn_update_dpp(0, v, 0x111, 0xf, 0xf, true);
  v += __builtin_amdgcn_update_dpp(0, v, 0x112, 0xf, 0xf, true);
  v += __builtin_amdgcn_update_dpp(0, v, 0x114, 0xf, 0xf, true);
  v += __builtin_amdgcn_update_dpp(0, v, 0x118, 0xf, 0xf, true);
  v += __builtin_amdgcn_update_dpp(0, v, 0x142, 0xa, 0xf, false);
  v += __builtin_amdgcn_update_dpp(0, v, 0x143, 0xc, 0xf, false);
  return v;
}

template <int NV, int R>
__device__ __forceinline__ void select_rows(const float* __restrict__ S0, int sstride, int n, unsigned short* __restrict__ sel0,
                                            int* red, int tid, int lane, int wave) {
  unsigned v[R][NV];
#pragma unroll
  for (int r = 0; r < R; ++r)
#pragma unroll
    for (int j = 0; j < NV; ++j)
      v[r][j] = __float_as_uint(S0[(size_t)r * sstride + j * 256 + tid]);
  asm volatile("" ::: "memory");
#pragma unroll
  for (int r = 0; r < R; ++r)
#pragma unroll
    for (int j = 0; j < NV; ++j) {
      const unsigned u = v[r][j];
      const unsigned k = (u & 0x80000000u) ? ~u : (u | 0x80000000u);
      v[r][j] = (j * 256 + tid < n) ? k : 0u;
    }
  unsigned T[R], thr[R]; bool done[R];
#pragma unroll
  for (int r = 0; r < R; ++r) { T[r] = 0u; thr[r] = 0u; done[r] = false; }
  for (int bit = 31; bit >= 0; --bit) {
    int* slot = red + ((bit & 1) << 4);
#pragma unroll
    for (int r = 0; r < R; ++r) {
      if (!done[r]) {
        const unsigned cand = T[r] | (1u << bit);
        int cnt = 0;
#pragma unroll
        for (int j = 0; j < NV; ++j) cnt += (v[r][j] >= cand) ? 1 : 0;
        cnt = wave_scan_add_i(cnt);
        if (lane == 63) slot[r * 4 + wave] = cnt;
      }
    }
    __syncthreads();
    bool all_done = true;
#pragma unroll
    for (int r = 0; r < R; ++r) {
      if (!done[r]) {
        const int total = slot[r * 4] + slot[r * 4 + 1] + slot[r * 4 + 2] + slot[r * 4 + 3];
        if (total >= 256) { T[r] |= (1u << bit); if (total == 256) { done[r] = true; thr[r] = T[r]; } }
      }
      all_done = all_done && done[r];
    }
    if (all_done) break;
  }
  const unsigned long long lt = (lane == 0) ? 0ull : (~0ull >> (64 - lane));
  int* pre = red + 32;
#pragma unroll
  for (int r = 0; r < R; ++r) {
    const bool exact = done[r];
    const unsigned th = exact ? thr[r] : (T[r] + 1u);
    int cl = 0;
#pragma unroll
    for (int j = 0; j < NV; ++j) cl += (v[r][j] >= th) ? 1 : 0;
    const int incl = wave_scan_add_i(cl);
    const int wtot = __builtin_amdgcn_readlane(incl, 63);
    __syncthreads();
    if (lane == 0) pre[wave] = wtot;
    __syncthreads();
    int base = incl - cl, tot = 0;
#pragma unroll
    for (int w2 = 0; w2 < 4; ++w2) { int c = pre[w2]; if (w2 < wave) base += c; tot += c; }
    unsigned short* selq = sel0 + (size_t)r * 256;
#pragma unroll
    for (int j = 0; j < NV; ++j) {
      if (v[r][j] >= th) { selq[base] = (unsigned short)(j * 256 + tid); ++base; }
    }
    if (!exact && wave == 0) {
      const int need_eq = 256 - tot;
      const float* S = S0 + (size_t)r * sstride;
      int filled = 0;
      for (int i0 = 0; i0 < n && filled < need_eq; i0 += 64) {
        const unsigned key = mono_key(S[i0 + lane]);
        const bool e = (key == T[r]);
        const unsigned long long m = __ballot(e);
        const int pos = filled + __popcll(m & lt);
        if (e && pos < need_eq) selq[tot + pos] = (unsigned short)(i0 + lane);
        filled += __popcll(m);
      }
    }
  }
}

__device__ __forceinline__ void idx_select_group(const Params& P, int band, int grp, char* smem) {
  const int tid = fresh_tid(), lane = tid & 63, wave = tid >> 6;
  const int r0 = grp * 4;
  const int q0 = band_q0(band) + r0;
  const int sstride = band_stride(band);
  const int n = 64 * ((q0 >> 6) + 1);
  unsigned short* sel0 = P.sel() + (size_t)q0 * 256;
  if (n <= 256) {
#pragma unroll
    for (int r = 0; r < 4; ++r) sel0[r * 256 + tid] = (unsigned short)(tid < n ? tid : 0);
    return;
  }
  int* red = (int*)smem;
  const float* S0 = P.out + (size_t)r0 * sstride;
  const int nfull = (n + 255) >> 8;
  if (nfull <= 8) select_rows<8, 4>(S0, sstride, n, sel0, red, tid, lane, wave);
  else if (nfull <= 16) select_rows<16, 4>(S0, sstride, n, sel0, red, tid, lane, wave);
  else if (nfull <= 24) {
    select_rows<24, 2>(S0, sstride, n, sel0, red, tid, lane, wave);
    __syncthreads();
    select_rows<24, 2>(S0 + 2 * (size_t)sstride, sstride, n, sel0 + 512, red, tid, lane, wave);
  } else if (nfull <= 32) {
    select_rows<32, 2>(S0, sstride, n, sel0, red, tid, lane, wave);
    __syncthreads();
    select_rows<32, 2>(S0 + 2 * (size_t)sstride, sstride, n, sel0 + 512, red, tid, lane, wave);
  } else if (nfull <= 48) {
#pragma unroll 1
    for (int r = 0; r < 4; ++r) {
      select_rows<48, 1>(S0 + r * (size_t)sstride, sstride, n, sel0 + r * 256, red, tid, lane, wave);
      __syncthreads();
    }
  } else {
#pragma unroll 1
    for (int r = 0; r < 4; ++r) {
      select_rows<64, 1>(S0 + r * (size_t)sstride, sstride, n, sel0 + r * 256, red, tid, lane, wave);
      __syncthreads();
    }
  }
}

__device__ __forceinline__ void attn_item(const Params& P, int item, char* smem) {
  const int tid = fresh_tid(), lane = tid & 63, wave = tid >> 6;
  const int gw = item * 4 + wave;
  const int q = gw >> 1, kvh = gw & 1;
  const int nsel = min(256, 64 * ((q >> 6) + 1));
  char* wsm = smem + wave * 6144;
  unsigned short* sidx = (unsigned short*)wsm;
  float* pbuf = (float*)(wsm + 512);
  float* psum = (float*)(wsm + 512 + 4096);
  __syncthreads();
  *(uint2*)(sidx + lane * 4) = *(const uint2*)(P.sel() + (size_t)q * 256 + lane * 4);
  const int hn = lane & 15, kg = lane >> 4;
  half8 qf[4];
#pragma unroll
  for (int ks = 0; ks < 4; ++ks) {
    half8 z = *(const half8*)(P.proj() + (size_t)q * NP + C_Q + (kvh * 4 + (hn & 3)) * 128 + ks * 32 + kg * 8);
    if (hn >= 4) {
#pragma unroll
      for (int j = 0; j < 8; ++j) z[j] = (half_t)0.f;
    }
    qf[ks] = z;
  }
  __syncthreads();
  const float scale = 0.08838834764831845f;
  float mx = -INFINITY;
#pragma unroll
  for (int tg = 0; tg < 8; ++tg) {
    half8 kf[2][4];
#pragma unroll
    for (int t = 0; t < 2; ++t) {
      const int idx = sidx[(tg * 2 + t) * 16 + hn];
      const half_t* kp = P.proj() + (size_t)idx * NP + C_K + kvh * 128 + kg * 8;
#pragma unroll
      for (int ks = 0; ks < 4; ++ks) kf[t][ks] = *(const half8*)(kp + ks * 32);
    }
    asm volatile("" ::: "memory");
#pragma unroll
    for (int t = 0; t < 2; ++t) {
      f32x4 sv = {0.f, 0.f, 0.f, 0.f};
#pragma unroll
      for (int ks = 0; ks < 4; ++ks) sv = __builtin_amdgcn_mfma_f32_16x16x32_f16(kf[t][ks], qf[ks], sv, 0, 0, 0);
#pragma unroll
      for (int i = 0; i < 4; ++i) {
        const int slot = (tg * 2 + t) * 16 + kg * 4 + i;
        const float x = (slot < nsel) ? sv[i] * scale : -INFINITY;
        mx = fmaxf(mx, x);
        if (hn < 4) pbuf[slot * 4 + hn] = x;
      }
    }
  }
  mx = fmaxf(mx, __shfl_xor(mx, 16, 64));
  mx = fmaxf(mx, __shfl_xor(mx, 32, 64));
  float sum = 0.f;
  if (hn < 4) {
#pragma unroll 4
    for (int t = 0; t < 16; ++t)
#pragma unroll
      for (int i = 0; i < 4; ++i) {
        const int slot = t * 16 + kg * 4 + i;
        const float p = __expf(pbuf[slot * 4 + hn] - mx);
        sum += p;
        pbuf[slot * 4 + hn] = p;
      }
  }
  sum += __shfl_xor(sum, 16, 64);
  sum += __shfl_xor(sum, 32, 64);
  if (lane < 4) psum[lane] = sum;
  __syncthreads();
  float o[4][8];
#pragma unroll
  for (int h = 0; h < 4; ++h)
#pragma unroll
    for (int d = 0; d < 8; ++d) o[h][d] = 0.f;
  const half_t* vbase = P.proj() + C_V + kvh * 128 + hn * 8;
  const int nq = nsel >> 2;
  for (int i0 = 0; i0 < nq; i0 += 4) {
    half8 vv[4];
#pragma unroll
    for (int u = 0; u < 4; ++u) {
      const int idx = sidx[4 * (i0 + u) + kg];
      vv[u] = *(const half8*)(vbase + (size_t)idx * NP);
    }
    asm volatile("" ::: "memory");
#pragma unroll
    for (int u = 0; u < 4; ++u) {
      const float4 p4 = *(const float4*)(pbuf + (4 * (i0 + u) + kg) * 4);
#pragma unroll
      for (int d = 0; d < 8; ++d) {
        const float vf = (float)vv[u][d];
        o[0][d] += p4.x * vf; o[1][d] += p4.y * vf; o[2][d] += p4.z * vf; o[3][d] += p4.w * vf;
      }
    }
  }
#pragma unroll
  for (int h = 0; h < 4; ++h)
#pragma unroll
    for (int d = 0; d < 8; ++d) {
      float v = o[h][d];
      v += __shfl_xor(v, 16, 64);
      v += __shfl_xor(v, 32, 64);
      o[h][d] = v;
    }
  {
    const int h = kg;
    const float inv = 1.0f / psum[h];
    const int col = (kvh * 4 + h) * 128 + hn * 8;
    const half8 gt = *(const half8*)(P.proj() + (size_t)q * NP + C_AG + col);
    half8 r;
#pragma unroll
    for (int d = 0; d < 8; ++d) {
      const float ov = (h == 0) ? o[0][d] : (h == 1) ? o[1][d] : (h == 2) ? o[2][d] : o[3][d];
      r[d] = (half_t)(ov * inv * siluf_((float)gt[d]));
    }
    *(half8*)(P.attg() + (size_t)q * 1024 + col) = r;
  }
}

#define FOR_TILES_XCD(NT, CALL)                                                          \
  for (int t = bid; t < 128 * (NT); t += nb) { int mt, nt; tile_coords(t, (NT), mt, nt); CALL; }

__device__ __forceinline__ void run_phase(const Params& P, int ph, char* smem) {
  const int nb = gridDim.x, bid = blockIdx.x;
  if (ph == 0) { for (int t = bid; t < T0_TOTAL; t += nb) prep_task(P, t, smem); }
  else if (ph == 1) { FOR_TILES_XCD(NP / 128, g1_tile(P, mt, nt, smem)) }
  else if (ph == 2) { for (int t = bid; t < 2048; t += nb) ssm_local(P, t, smem, false); }
  else if (ph == 3) { if (bid < 8) ssm_carry(P, bid); }
  else if (ph == 4) { for (int t = bid; t < 2048; t += nb) ssm_local(P, t, smem, true); }
  else if (ph == 5) { for (int t = bid; t < 128 * 4; t += nb) { int mt, nt; tile_coords(t, 4, mt, nt); g3_tile(P, mt, nt, smem); } }
  else if (ph < 22) {
    const int b = (ph - 6) >> 1;
    if (((ph - 6) & 1) == 0) {
      const int nitems = 128 * ((BAND * (b + 1)) / KP);
      for (int t = bid; t < nitems; t += nb) idx_score_item(P, b, t, smem);
    } else {
      for (int t = bid; t < BAND / 4; t += nb) { __syncthreads(); idx_select_group(P, b, t, smem); }
    }
  }
  else if (ph == 22) { for (int t = bid; t < L * 2 / 4; t += nb) attn_item(P, t, smem); }
  else if (ph == 23) { FOR_TILES_XCD(16, { g24_tile<0>(P, mt, nt, smem); g24_tile<1>(P, mt, nt, smem); }) }
  else if (ph == 24) { FOR_TILES_XCD(16, g5_tile(P, mt, nt, smem)) }
  else if (ph == 25) { for (int t = bid; t < L / 4; t += nb) fn_task(P, t); }
}

#if !MEGA
template <int PH>
__global__ void __launch_bounds__(256, 3) k_ph(Params P) {
  __shared__ __attribute__((aligned(16))) char smem[SMEM_BYTES];
  run_phase(P, PH, smem);
}
__global__ void __launch_bounds__(256, 3) k_score(Params P, int b) {
  __shared__ __attribute__((aligned(16))) char smem[SMEM_BYTES];
  const int nb = gridDim.x, bid = blockIdx.x;
  const int nitems = 128 * ((BAND * (b + 1)) / KP);
  for (int t = bid; t < nitems; t += nb) idx_score_item(P, b, t, smem);
}
__global__ void __launch_bounds__(256, 3) k_select(Params P, int b) {
  __shared__ __attribute__((aligned(16))) char smem[SMEM_BYTES];
  const int nb = gridDim.x, bid = blockIdx.x;
  for (int t = bid; t < BAND / 4; t += nb) { __syncthreads(); idx_select_group(P, b, t, smem); }
}

#endif
#if MEGA
__global__ void __launch_bounds__(256, 3) k_mega(Params P) {
  __shared__ __attribute__((aligned(16))) char smem[SMEM_BYTES];
  cg::grid_group grid = cg::this_grid();
  __shared__ uint4 xb_words;
  if (threadIdx.x == 0) xb_words = make_uint4(0u, 0u, 0u, 0u);
  __syncthreads();
  XcdBarrier xb = xcd_barrier_post(P.bar(), (volatile LAS unsigned*)&xb_words);
  if (P.out == nullptr) grid.sync();
  const int nb = gridDim.x, bid = blockIdx.x;
  for (int r = 0; r < REP_P0; ++r) { run_phase(P, 0, smem); xcd_barrier(xb); }
  for (int r = 0; r < REP_G1; ++r) { run_phase(P, 1, smem); xcd_barrier(xb); }
  for (int b = 0; b < NBAND; ++b) {
    {
      const int n_sc = (band_rows(b) >> 4) * ((band_q0(b) + band_rows(b) + KP - 1) / KP);
      const int n_ex = (b == 0 || b == 1) ? 2048 : (b == 2 ? 512 : 0);
      const int n_at = (b >= 1) ? (band_rows(b - 1) * 2 / 4) : 0;
      const int at0 = (b >= 1) ? (band_q0(b - 1) * 2 / 4) : 0;
      for (int t = bid; t < n_sc; t += nb) idx_score_item(P, b, t, smem);
      const int r1 = (bid + nb - (n_sc % nb)) % nb;
      if (b == 0) { for (int u = r1; u < n_ex; u += nb) ssm_local(P, u, smem, false); }
      else if (b == 1) { for (int u = r1; u < n_ex; u += nb) ssm_local(P, u, smem, true); }
      else if (b == 2) { for (int u = r1; u < n_ex; u += nb) { int mt, nt; tile_coords(u, 4, mt, nt); g3_tile(P, mt, nt, smem); } }
      const int r2 = (r1 + nb - (n_ex % nb)) % nb;
      for (int u = r2; u < n_at; u += nb) attn_item(P, at0 + u, smem);
    }
    xcd_barrier(xb);
    if (b == 0 && bid >= nb - 8) ssm_carry(P, bid - (nb - 8));
    else for (int t = bid; t < band_rows(b) / 4; t += (b == 0 ? nb - 8 : nb)) { __syncthreads(); idx_select_group(P, b, t, smem); }
    xcd_barrier(xb);
  }
  for (int t = bid; t < band_rows(NBAND - 1) * 2 / 4; t += nb) attn_item(P, band_q0(NBAND - 1) * 2 / 4 + t, smem);
  xcd_barrier(xb);
  run_phase(P, 23, smem); xcd_barrier(xb);
  for (int r = 0; r < REP_G5; ++r) { run_phase(P, 24, smem); xcd_barrier(xb); }
  run_phase(P, 25, smem);
}
#endif

extern "C" void kernel_launch(void* const* d_in, const int* in_sizes, int n_in, void* d_out, int out_size,
                              void* d_ws, size_t ws_size, hipStream_t stream) {
  Params p{};
  p.x = (const float*)d_in[0]; p.pos = (const int*)d_in[1]; p.g_norm = (const float*)d_in[2];
  p.w_in = (const float*)d_in[3]; p.b_merge = (const float*)d_in[4]; p.a_re = (const float*)d_in[5];
  p.a_im = (const float*)d_in[6]; p.log_dt = (const float*)d_in[7]; p.b_re = (const float*)d_in[8];
  p.b_im = (const float*)d_in[9]; p.c_re = (const float*)d_in[10]; p.c_im = (const float*)d_in[11];
  p.ssm_d = (const float*)d_in[12]; p.w_glu = (const float*)d_in[13]; p.b_glu = (const float*)d_in[14];
  p.w_att_out = (const float*)d_in[15]; p.w_ssm_out = (const float*)d_in[16]; p.w_out = (const float*)d_in[17];
  p.g_final = (const float*)d_in[18];
  p.out = (float*)d_out;
  p.ws = (char*)d_ws;
  size_t off = WS_NEEDED;
  if (off > ws_size) { fprintf(stderr, "workspace too small: need %zu have %zu\n", off, ws_size); return; }
#if MEGA
  static int grid_blocks = 0;
  if (!grid_blocks) {
    int dev = 0, cus = 0, per_cu = 0;
    hipGetDevice(&dev);
    hipDeviceGetAttribute(&cus, hipDeviceAttributeMultiprocessorCount, dev);
    hipOccupancyMaxActiveBlocksPerMultiprocessor(&per_cu, k_mega, 256, 0);
    if (per_cu > 3) per_cu = 3;
    grid_blocks = cus * per_cu;
  }
  hipMemsetAsync(p.bar(), 0, XCD_BAR_WORDS * 4, stream);
  void* args[] = {&p};
  hipError_t e = hipLaunchCooperativeKernel((void*)k_mega, dim3(grid_blocks), dim3(256), args, 0, stream);
  if (e != hipSuccess) fprintf(stderr, "cooperative launch failed: %s (grid %d)\n", hipGetErrorString(e), grid_blocks);
#else
  k_ph<0><<<1024, 256, 0, stream>>>(p);
  k_ph<1><<<512, 256, 0, stream>>>(p);
  k_ph<2><<<512, 256, 0, stream>>>(p);
  k_ph<3><<<8, 256, 0, stream>>>(p);
  k_ph<4><<<512, 256, 0, stream>>>(p);
  k_ph<5><<<512, 256, 0, stream>>>(p);
  for (int b = 0; b < 8; ++b) { k_score<<<512, 256, 0, stream>>>(p, b); k_select<<<1024, 256, 0, stream>>>(p, b); }
  k_ph<22><<<1024, 256, 0, stream>>>(p);
  k_ph<23><<<512, 256, 0, stream>>>(p);
  k_ph<24><<<512, 256, 0, stream>>>(p);
  k_ph<25><<<1024, 256, 0, stream>>>(p);
#endif
}
```

```cpp
#include <hip/hip_runtime.h>
#include <hip/hip_cooperative_groups.h>
#include <stdint.h>
#include <stdio.h>
namespace cg = cooperative_groups;

#ifndef MEGA
#define MEGA 1
#endif
#ifndef REP_G1
#define REP_G1 1
#endif
#ifndef REP_SC
#define REP_SC 1
#endif
#ifndef REP_SEL
#define REP_SEL 1
#endif
#ifndef REP_ATT
#define REP_ATT 1
#endif
#ifndef REP_SSM
#define REP_SSM 1
#endif
#ifndef REP_G24
#define REP_G24 1
#endif
#ifndef REP_P0
#define REP_P0 1
#endif
#ifndef REP_S3
#define REP_S3 1
#endif
#ifndef REP_G3
#define REP_G3 1
#endif
#ifndef REP_G5
#define REP_G5 1
#endif

typedef _Float16 half_t;
typedef _Float16 half8 __attribute__((ext_vector_type(8)));
typedef _Float16 half4 __attribute__((ext_vector_type(4)));
typedef _Float16 half2v __attribute__((ext_vector_type(2)));
typedef float f32x16 __attribute__((ext_vector_type(16)));
typedef float f32x4 __attribute__((ext_vector_type(4)));
typedef unsigned int u32x4 __attribute__((ext_vector_type(4)));

constexpr int L = 16384, D = 2048, NIN = 8784, NP = 8832;
constexpr int C_Q = 0, C_K = 1024, C_V = 1280, C_AG = 1536, C_QI = 2560, C_KI = 3584, C_U = 3648,
              C_SG = 4160, C_MG = 4672, C_WI = 8768;
constexpr int SMEM_BYTES = 53248;
constexpr int BAND = 2048;
constexpr int NBAND = 4;
__device__ __host__ __forceinline__ constexpr int band_q0(int b) { return b == 0 ? 0 : b == 1 ? 6976 : b == 2 ? 11264 : b == 3 ? 14592 : 16384; }
__device__ __host__ __forceinline__ constexpr int band_rows(int b) { return band_q0(b + 1) - band_q0(b); }
__device__ __host__ __forceinline__ constexpr int band_stride(int b) { return band_q0(b + 1); }
__device__ __host__ __forceinline__ constexpr int band_split(int b) { return b == 0 ? 4800 : b == 1 ? 2976 : b == 2 ? 2288 : 1792; }
constexpr int KP = 1024;
constexpr int NPHASE = 26;

constexpr size_t al256(size_t x) { return (x + 255) & ~(size_t)255; }
constexpr size_t OFF_proj = 0;
constexpr size_t OFF_kidx = OFF_proj + al256((size_t)L * NP * 2);
constexpr size_t OFF_h = OFF_kidx + al256((size_t)L * 64 * 2);
constexpr size_t OFF_wt_in = OFF_h + al256((size_t)L * D * 2);
constexpr size_t OFF_wt_att = OFF_wt_in + al256((size_t)NP * D * 2);
constexpr size_t OFF_wt_glu = OFF_wt_att + al256((size_t)2048 * 1024 * 2);
constexpr size_t OFF_wt_ssm = OFF_wt_glu + al256((size_t)512 * 512 * 2);
constexpr size_t OFF_wt_out = OFF_wt_ssm + al256((size_t)2048 * 512 * 2);
constexpr size_t OFF_s1 = OFF_wt_out + al256((size_t)2048 * 2048 * 2);
constexpr size_t OFF_sg = OFF_s1 + al256((size_t)L * 512 * 2);
constexpr size_t OFF_attg = OFF_sg + al256((size_t)L * 512 * 2);
constexpr size_t OFF_cmT = OFF_attg + al256((size_t)L * 1024 * 2);
constexpr size_t OFF_cos128 = OFF_cmT + al256((size_t)32 * 16 * 128 * 2);
constexpr size_t OFF_sin128 = OFF_cos128 + al256((size_t)L * 16 * 4);
constexpr size_t OFF_cos64 = OFF_sin128 + al256((size_t)L * 16 * 4);
constexpr size_t OFF_sin64 = OFF_cos64 + al256((size_t)L * 8 * 4);
constexpr size_t OFF_lam = OFF_sin64 + al256((size_t)L * 8 * 4);
constexpr size_t OFF_bb = OFF_lam + al256((size_t)2048 * 2 * 4);
constexpr size_t OFF_E = OFF_bb + al256((size_t)2048 * 32 * 4);
constexpr size_t OFF_sel = OFF_E + al256((size_t)256 * 2048 * 2 * 4);
constexpr size_t OFF_bar = OFF_sel + al256((size_t)L * 256 * 2);
constexpr size_t WS_NEEDED = OFF_bar + al256((size_t)3456 * 4);
struct Params {
  const float* x; const int* pos; const float* g_norm; const float* w_in; const float* b_merge;
  const float* a_re; const float* a_im; const float* log_dt; const float* b_re; const float* b_im;
  const float* c_re; const float* c_im; const float* ssm_d; const float* w_glu; const float* b_glu;
  const float* w_att_out; const float* w_ssm_out; const float* w_out; const float* g_final;
  float* out;
  char* ws;
  __device__ __host__ __forceinline__ half_t* proj() const { return (half_t*)(ws + OFF_proj); }
  __device__ __host__ __forceinline__ half_t* kidx() const { return (half_t*)(ws + OFF_kidx); }
  __device__ __host__ __forceinline__ half_t* h() const { return (half_t*)(ws + OFF_h); }
  __device__ __host__ __forceinline__ half_t* wt_in() const { return (half_t*)(ws + OFF_wt_in); }
  __device__ __host__ __forceinline__ half_t* wt_att() const { return (half_t*)(ws + OFF_wt_att); }
  __device__ __host__ __forceinline__ half_t* wt_glu() const { return (half_t*)(ws + OFF_wt_glu); }
  __device__ __host__ __forceinline__ half_t* wt_ssm() const { return (half_t*)(ws + OFF_wt_ssm); }
  __device__ __host__ __forceinline__ half_t* wt_out() const { return (half_t*)(ws + OFF_wt_out); }
  __device__ __host__ __forceinline__ half_t* s1() const { return (half_t*)(ws + OFF_s1); }
  __device__ __host__ __forceinline__ half_t* sg() const { return (half_t*)(ws + OFF_sg); }
  __device__ __host__ __forceinline__ half_t* attg() const { return (half_t*)(ws + OFF_attg); }
  __device__ __host__ __forceinline__ half_t* cmT() const { return (half_t*)(ws + OFF_cmT); }
  __device__ __host__ __forceinline__ float* cos128() const { return (float*)(ws + OFF_cos128); }
  __device__ __host__ __forceinline__ float* sin128() const { return (float*)(ws + OFF_sin128); }
  __device__ __host__ __forceinline__ float* cos64() const { return (float*)(ws + OFF_cos64); }
  __device__ __host__ __forceinline__ float* sin64() const { return (float*)(ws + OFF_sin64); }
  __device__ __host__ __forceinline__ float* lam() const { return (float*)(ws + OFF_lam); }
  __device__ __host__ __forceinline__ float* bb() const { return (float*)(ws + OFF_bb); }
  __device__ __host__ __forceinline__ float* E() const { return (float*)(ws + OFF_E); }
  __device__ __host__ __forceinline__ unsigned short* sel() const { return (unsigned short*)(ws + OFF_sel); }
  __device__ __host__ __forceinline__ unsigned* bar() const { return (unsigned*)(ws + OFF_bar); }
};


#define XB_TMO      128
#define XB_XCNT(j)  (256  + 64 * (j))
#define XB_XSUB(j)  (1280 + 64 * (j))
#define XB_XGEN(j)  (2304 + 64 * (j))
#define XB_TOP      3328
#define XB_TOPGEN   3392
#define XCD_BAR_WORDS 3456
#define XB_SPIN_CAP (1u << 18)
#define LAS __attribute__((address_space(3)))

__device__ __forceinline__ unsigned xb_ld(unsigned* p)              { return __hip_atomic_load(p, __ATOMIC_RELAXED, __HIP_MEMORY_SCOPE_AGENT); }
__device__ __forceinline__ unsigned xb_add(unsigned* p, unsigned v) { return __hip_atomic_fetch_add(p, v, __ATOMIC_RELAXED, __HIP_MEMORY_SCOPE_AGENT); }
__device__ __forceinline__ unsigned xb_xcc_id() { return (unsigned)__builtin_amdgcn_s_getreg((3 << 11) | 20) & 0xFu; }
#define XB_SPIN(cond, bar) do { unsigned _sp = 0; while (cond) { __builtin_amdgcn_s_sleep(1); \
    if ((++_sp & 255u) == 0u) { if (xb_ld(&(bar)[XB_TMO])) break; if (_sp > XB_SPIN_CAP) { atomicAdd(&(bar)[XB_TMO], 1u); break; } } } } while (0)

struct XcdBarrier { unsigned* bar; unsigned x; volatile LAS unsigned* st; };

__device__ __forceinline__ XcdBarrier xcd_barrier_post(unsigned* bar, volatile LAS unsigned* st) {
    XcdBarrier b; b.bar = bar; b.x = xb_xcc_id(); b.st = st;
    if (threadIdx.x == 0) (void)xb_add(&bar[XB_XCNT(b.x)], 1u);
    return b;
}
__device__ __forceinline__ void xcd_barrier_complete(unsigned* bar, unsigned x, unsigned& nloc, unsigned& nx) {
    const unsigned G = gridDim.x * gridDim.y * gridDim.z;
    unsigned sum, cnt, mine, sp = 0u;
    for (;;) {
        sum = 0u; cnt = 0u; mine = 0u;
#pragma unroll
        for (unsigned j = 0; j < 16; ++j) { const unsigned c = xb_ld(&bar[XB_XCNT(j)]); sum += c; cnt += (c > 0u) ? 1u : 0u; mine = (j == x) ? c : mine; }
        if (sum == G) break;
        __builtin_amdgcn_s_sleep(1);
        if ((++sp & 255u) == 0u) { if (xb_ld(&bar[XB_TMO])) break; if (sp > XB_SPIN_CAP) { atomicAdd(&bar[XB_TMO], 1u); break; } }
    }
    nloc = mine > 0u ? mine : 1u; nx = cnt > 0u ? cnt : 1u;
}
__device__ __forceinline__ void xcd_barrier(const XcdBarrier& b) {
    asm volatile("s_waitcnt vmcnt(0)" ::: "memory");
    __syncthreads();
    if (threadIdx.x == 0) {
        unsigned* bar = b.bar;
        __builtin_amdgcn_s_waitcnt(0);
        unsigned nloc = b.st[0], nx = b.st[1];
        if (nloc == 0u) { xcd_barrier_complete(bar, b.x, nloc, nx); b.st[0] = nloc; b.st[1] = nx; }
        const unsigned old = xb_add(&bar[XB_XSUB(b.x)], 1u);
        const unsigned gen = old / nloc;
        if (old + 1u == (gen + 1u) * nloc) {
            __builtin_amdgcn_fence(__ATOMIC_RELEASE, "agent");
            asm volatile("s_waitcnt vmcnt(0)" ::: "memory");
            const unsigned og = xb_add(&bar[XB_TOP], 1u);
            const unsigned tg = og / nx;
            if (og + 1u == (tg + 1u) * nx) xb_add(&bar[XB_TOPGEN], 1u);
            else XB_SPIN(xb_ld(&bar[XB_TOPGEN]) == tg, bar);
            __builtin_amdgcn_fence(__ATOMIC_ACQUIRE, "agent");
            xb_add(&bar[XB_XGEN(b.x)], 1u);
            asm volatile("s_waitcnt vmcnt(0)" ::: "memory");
        } else {
            XB_SPIN(xb_ld(&bar[XB_XGEN(b.x)]) == gen, bar);
            __builtin_amdgcn_fence(__ATOMIC_ACQUIRE, "agent");
            asm volatile("s_waitcnt vmcnt(0)" ::: "memory");
        }
    }
    __syncthreads();
}

__device__ __forceinline__ int fresh_tid() { int t = threadIdx.x; asm volatile("" : "+v"(t)); return t; }
__device__ __forceinline__ float wave_sum(float v) {
#pragma unroll
  for (int o = 32; o > 0; o >>= 1) v += __shfl_xor(v, o, 64);
  return v;
}
__device__ __forceinline__ float sigmoidf_(float x) { return 1.0f / (1.0f + __expf(-x)); }
__device__ __forceinline__ float siluf_(float x) { return x / (1.0f + __expf(-x)); }
__device__ __forceinline__ float gelu_tanh(float x) {
  float u = 0.7978845608028654f * (x + 0.044715f * x * x * x);
  float t = 1.0f - 2.0f / (__expf(2.0f * u) + 1.0f);
  return 0.5f * x * (1.0f + t);
}

constexpr int T0_NORM = L / 4;
constexpr int T0_WIN = (D / 64) * (NP / 64);
constexpr int T0_WATT = (1024 / 64) * (2048 / 64);
constexpr int T0_WGLU = (512 / 64) * (512 / 64);
constexpr int T0_WSSM = (512 / 64) * (2048 / 64);
constexpr int T0_WOUT = (2048 / 64) * (2048 / 64);
constexpr int T0_ROT = (L * 24) / 256;
constexpr int T0_SSM = 8;
constexpr int T0_TOTAL = T0_NORM + T0_WIN + T0_WATT + T0_WGLU + T0_WSSM + T0_WOUT + T0_ROT + T0_SSM;

__device__ __forceinline__ int remap_col(int np) {
  if (np < 3648) return np;
  if (np < 8768) return np + 16;
  if (np < 8784) return np - 8768 + 3648;
  return -1;
}

__device__ __forceinline__ void transpose_tile(const float* __restrict__ W, int K, int N, half_t* __restrict__ Wt,
                               int kt, int nt, bool remap, char* smem) {
  half_t* t = (half_t*)smem;
  const int tid = fresh_tid();
  {
    const int nn = tid & 63;
    const int np = nt * 64 + nn;
    const int n = remap ? remap_col(np) : np;
    const int nc = n >= 0 ? n : 0;
    float wv[16];
#pragma unroll
    for (int i = 0; i < 16; ++i) wv[i] = W[(size_t)(kt * 64 + (tid >> 6) + 4 * i) * N + nc];
    asm volatile("" ::: "memory");
#pragma unroll
    for (int i = 0; i < 16; ++i) t[nn * 66 + (tid >> 6) + 4 * i] = (half_t)(n >= 0 ? wv[i] : 0.0f);
  }
  __syncthreads();
#pragma unroll 4
  for (int i = 0; i < 8; ++i) {
    int e = tid + 256 * i;
    int nn = e >> 5, kp = e & 31;
    half2v v; v.x = t[nn * 66 + kp * 2]; v.y = t[nn * 66 + kp * 2 + 1];
    *(half2v*)(Wt + (size_t)(nt * 64 + nn) * K + kt * 64 + kp * 2) = v;
  }
  __syncthreads();
}

__device__ __forceinline__ void prep_task(const Params& P, int t, char* smem) {
  const int tid = fresh_tid(), lane = tid & 63, wave = tid >> 6;
  if (t < T0_NORM) {
    int row = t * 4 + wave;
    const float4* xr = (const float4*)(P.x + (size_t)row * D);
    float4 v[8]; float ss = 0.f;
#pragma unroll
    for (int j = 0; j < 8; ++j) { v[j] = xr[j * 64 + lane]; ss += v[j].x * v[j].x + v[j].y * v[j].y + v[j].z * v[j].z + v[j].w * v[j].w; }
    ss = wave_sum(ss);
    float sc = rsqrtf(ss * (1.0f / D) + 1e-6f);
    const float4* g4 = (const float4*)P.g_norm;
#pragma unroll
    for (int j = 0; j < 8; ++j) {
      float4 g = g4[j * 64 + lane];
      half4 o; o.x = (half_t)(v[j].x * sc * g.x); o.y = (half_t)(v[j].y * sc * g.y);
      o.z = (half_t)(v[j].z * sc * g.z); o.w = (half_t)(v[j].w * sc * g.w);
      *(half4*)(P.h() + (size_t)row * D + (j * 64 + lane) * 4) = o;
    }
    return;
  }
  t -= T0_NORM;
  if (t < T0_WIN) { transpose_tile(P.w_in, D, NIN, P.wt_in(), t % 32, t / 32, true, smem); return; }
  t -= T0_WIN;
  if (t < T0_WATT) { transpose_tile(P.w_att_out, 1024, 2048, P.wt_att(), t % 16, t / 16, false, smem); return; }
  t -= T0_WATT;
  if (t < T0_WGLU) { transpose_tile(P.w_glu, 512, 512, P.wt_glu(), t % 8, t / 8, false, smem); return; }
  t -= T0_WGLU;
  if (t < T0_WSSM) { transpose_tile(P.w_ssm_out, 512, 2048, P.wt_ssm(), t % 8, t / 8, false, smem); return; }
  t -= T0_WSSM;
  if (t < T0_WOUT) { transpose_tile(P.w_out, 2048, 2048, P.wt_out(), t % 32, t / 32, false, smem); return; }
  t -= T0_WOUT;
  if (t < T0_ROT) {
    int e = t * 256 + tid;
    int tok = e / 24, i = e % 24;
    float a;
    if (i < 16) { a = (-13.122363377404328f) * (float)i; a = a * (2.0f / 32.0f); }
    else        { a = (-13.122363377404328f) * (float)(i - 16); a = a * (2.0f / 16.0f); }
    float inv = expf(a);
    float ang = (float)P.pos[tok] * inv;
    double rev = (double)ang * 0.15915494309189535;
    rev = rev - rint(rev);
    float fr = (float)rev;
    float s = __builtin_amdgcn_sinf(fr);
    float c = __builtin_amdgcn_cosf(fr);
    if (i < 16) { P.cos128()[tok * 16 + i] = c; P.sin128()[tok * 16 + i] = s; }
    else        { P.cos64()[tok * 8 + i - 16] = c; P.sin64()[tok * 8 + i - 16] = s; }
    return;
  }
  t -= T0_ROT;
  {
    int gp = t * 256 + tid;
    int g = gp >> 6, p = gp & 63;
    float dt = expf(P.log_dt[g]);
    float ar = P.a_re[gp], ai = P.a_im[gp];
    float mag = expf(ar * dt);
    float ang = ai * dt;
    double rev = (double)ang * 0.15915494309189535;
    rev = rev - rint(rev);
    float fr = (float)rev;
    float lr = mag * __builtin_amdgcn_cosf(fr);
    float li = mag * __builtin_amdgcn_sinf(fr);
    float den = ar * ar + ai * ai;
    float cr = ((lr - 1.0f) * ar + li * ai) / den;
    float ci = (li * ar - (lr - 1.0f) * ai) / den;
    P.lam()[gp * 2] = lr; P.lam()[gp * 2 + 1] = li;
    for (int c = 0; c < 16; ++c) {
      float br = P.b_re[gp * 16 + c], bi = P.b_im[gp * 16 + c];
      P.bb()[gp * 32 + c] = cr * br - ci * bi;
      P.bb()[gp * 32 + 16 + c] = cr * bi + ci * br;
      P.cmT()[(g * 16 + c) * 128 + p] = (half_t)P.c_re[(g * 16 + c) * 64 + p];
      P.cmT()[(g * 16 + c) * 128 + 64 + p] = (half_t)(-P.c_im[(g * 16 + c) * 64 + p]);
    }
  }
}

constexpr int LDS_ROW = 144;
constexpr int LDS_TILE = 128 * LDS_ROW;
constexpr int LDS_STAGE = 2 * LDS_TILE;

__device__ __forceinline__ void gemm_loop(const half_t* __restrict__ A, int lda, const half_t* __restrict__ B,
                                          int ldb, int K, int m0, int n0, f32x16 (&acc)[2][2], char* smem) {
  const int tid = fresh_tid(), lane = tid & 63, wave = tid >> 6;
  const int wm = wave >> 1, wn = wave & 1;
  const int lrow = tid >> 3, lkc = tid & 7;
  const half_t* ga = A + (size_t)(m0 + lrow) * lda + lkc * 8;
  const half_t* gb = B + (size_t)(n0 + lrow) * ldb + lkc * 8;
  u32x4 ra[4], rb[4];
  const int KT = K >> 6;
#pragma unroll
  for (int i = 0; i < 4; ++i) {
    ra[i] = *(const u32x4*)(ga + (size_t)(32 * i) * lda);
    rb[i] = *(const u32x4*)(gb + (size_t)(32 * i) * ldb);
  }
  const int arow = (wm * 64 + (lane & 31)) * LDS_ROW + (lane >> 5) * 16;
  const int brow = LDS_TILE + (wn * 64 + (lane & 31)) * LDS_ROW + (lane >> 5) * 16;
  for (int kt = 0; kt < KT; ++kt) {
    __syncthreads();
#pragma unroll
    for (int i = 0; i < 4; ++i) {
      *(u32x4*)(smem + (lrow + 32 * i) * LDS_ROW + lkc * 16) = ra[i];
      *(u32x4*)(smem + LDS_TILE + (lrow + 32 * i) * LDS_ROW + lkc * 16) = rb[i];
    }
    {
      const int kn = (kt + 1 < KT) ? kt + 1 : kt;
#pragma unroll
      for (int i = 0; i < 4; ++i) {
        ra[i] = *(const u32x4*)(ga + (size_t)(32 * i) * lda + kn * 64);
        rb[i] = *(const u32x4*)(gb + (size_t)(32 * i) * ldb + kn * 64);
      }
    }
    __syncthreads();
#pragma unroll
    for (int ks = 0; ks < 4; ++ks) {
      half8 a0 = *(const half8*)(smem + arow + ks * 32);
      half8 a1 = *(const half8*)(smem + arow + 32 * LDS_ROW + ks * 32);
      half8 b0 = *(const half8*)(smem + brow + ks * 32);
      half8 b1 = *(const half8*)(smem + brow + 32 * LDS_ROW + ks * 32);
      acc[0][0] = __builtin_amdgcn_mfma_f32_32x32x16_f16(a0, b0, acc[0][0], 0, 0, 0);
      acc[0][1] = __builtin_amdgcn_mfma_f32_32x32x16_f16(a0, b1, acc[0][1], 0, 0, 0);
      acc[1][0] = __builtin_amdgcn_mfma_f32_32x32x16_f16(a1, b0, acc[1][0], 0, 0, 0);
      acc[1][1] = __builtin_amdgcn_mfma_f32_32x32x16_f16(a1, b1, acc[1][1], 0, 0, 0);
      if (ks & 1) asm volatile("" ::: "memory");
    }
  }
  __builtin_amdgcn_sched_barrier(0);
  __syncthreads();
  __builtin_amdgcn_sched_barrier(0);
}

#define ACC_ROW(mt, i) (wm * 64 + (mt) * 32 + ((i) & 3) + 8 * ((i) >> 2) + 4 * (lane >> 5))
#define ACC_COL(nt) (wn * 64 + (nt) * 32 + (lane & 31))

constexpr int CS_STRIDE = 136;

__device__ __forceinline__ void tile_coords(int t, int NT, int& mt, int& nt) {
  int per = 16 * NT;
  int grp = t / per, r = t - grp * per;
  nt = r >> 4; mt = grp * 16 + (r & 15);
}

__device__ __forceinline__ void g1_tile(const Params& P, int mt, int nt, char* smem) {
  const int tid = fresh_tid(), lane = tid & 63, wave = tid >> 6;
  const int wm = wave >> 1, wn = wave & 1;
  const int m0 = mt * 128, n0 = nt * 128;
  f32x16 acc[2][2];
#pragma unroll
  for (int a = 0; a < 2; ++a)
#pragma unroll
    for (int b = 0; b < 2; ++b)
#pragma unroll
      for (int i = 0; i < 16; ++i) acc[a][b][i] = 0.f;
  gemm_loop(P.h(), D, P.wt_in(), D, D, m0, n0, acc, smem);
  half_t* cs = (half_t*)smem;
  half_t* csw = cs + (wm * 64 + 4 * (lane >> 5)) * CS_STRIDE + wn * 64 + (lane & 31);
#pragma unroll
  for (int a = 0; a < 2; ++a)
#pragma unroll
    for (int b = 0; b < 2; ++b) {
      const float sc = (n0 + ACC_COL(b) >= C_WI) ? (1.0f / 32.0f) : 1.0f;
#pragma unroll
      for (int i = 0; i < 16; ++i) csw[(a * 32 + (i & 3) + 8 * (i >> 2)) * CS_STRIDE + b * 32] = (half_t)(acc[a][b][i] * sc);
    }
  __syncthreads();
#pragma unroll 2
  for (int i = 0; i < 8; ++i) {
    int c = tid + 256 * i;
    int row = c >> 4, cc = (c & 15) * 8;
    int n = n0 + cc, m = m0 + row;
    half8 v = *(const half8*)(cs + row * CS_STRIDE + cc);
    if (n < C_V) {
      int d = n & 127;
      if (d < 32) {
        const bool lo = d < 16;
        half8 o = *(const half8*)(cs + row * CS_STRIDE + (lo ? cc + 16 : cc - 16));
        const int fi = lo ? d : d - 16;
        const float* cp = P.cos128() + (size_t)m * 16 + fi;
        const float* sp = P.sin128() + (size_t)m * 16 + fi;
        half8 r;
#pragma unroll
        for (int j = 0; j < 8; ++j) {
          float cv = cp[j], sv = sp[j];
          float x1 = lo ? (float)v[j] : (float)o[j];
          float x2 = lo ? (float)o[j] : (float)v[j];
          r[j] = (half_t)(lo ? (x1 * cv - x2 * sv) : (x2 * cv + x1 * sv));
        }
        v = r;
      }
    } else if (n >= C_QI && n < C_U) {
      int d = n & 63;
      if (d < 16) {
        const bool lo = d < 8;
        half8 o = *(const half8*)(cs + row * CS_STRIDE + (lo ? cc + 8 : cc - 8));
        const float* cp = P.cos64() + (size_t)m * 8;
        const float* sp = P.sin64() + (size_t)m * 8;
        half8 r;
#pragma unroll
        for (int j = 0; j < 8; ++j) {
          float cv = cp[j], sv = sp[j];
          float x1 = lo ? (float)v[j] : (float)o[j];
          float x2 = lo ? (float)o[j] : (float)v[j];
          r[j] = (half_t)(lo ? (x1 * cv - x2 * sv) : (x2 * cv + x1 * sv));
        }
        v = r;
      }
    }
    if (n >= C_KI && n < C_U) *(half8*)(P.kidx() + (size_t)m * 64 + (n - C_KI)) = v;
    else *(half8*)(P.proj() + (size_t)m * NP + n) = v;
  }
}

__device__ __forceinline__ void g3_tile(const Params& P, int mt, int nt, char* smem) {
  const int tid = fresh_tid(), lane = tid & 63, wave = tid >> 6;
  const int wm = wave >> 1, wn = wave & 1;
  const int m0 = mt * 128, n0 = nt * 128;
  f32x16 acc[2][2];
#pragma unroll
  for (int a = 0; a < 2; ++a)
#pragma unroll
    for (int b = 0; b < 2; ++b)
#pragma unroll
      for (int i = 0; i < 16; ++i) acc[a][b][i] = 0.f;
  gemm_loop(P.s1(), 512, P.wt_glu(), 512, 512, m0, n0, acc, smem);
  half_t* cs = (half_t*)smem;
  half_t* csw = cs + (wm * 64 + 4 * (lane >> 5)) * CS_STRIDE + wn * 64 + (lane & 31);
#pragma unroll
  for (int a = 0; a < 2; ++a)
#pragma unroll
    for (int b = 0; b < 2; ++b) {
      const int col = ACC_COL(b);
      const int n = n0 + col;
      const float bg = P.b_glu[n];
#pragma unroll
      for (int i0 = 0; i0 < 16; i0 += 8) {
        half_t s1h[8], gth[8];
#pragma unroll
        for (int i = 0; i < 8; ++i) {
          const size_t m = m0 + ACC_ROW(a, i0 + i);
          s1h[i] = P.s1()[m * 512 + n];
          gth[i] = P.proj()[m * NP + C_SG + n];
        }
        asm volatile("" ::: "memory");
#pragma unroll
        for (int i = 0; i < 8; ++i) {
          float v = (float)s1h[i] * sigmoidf_(acc[a][b][i0 + i] + bg) * siluf_((float)gth[i]);
          csw[(a * 32 + ((i0 + i) & 3) + 8 * ((i0 + i) >> 2)) * CS_STRIDE + b * 32] = (half_t)v;
        }
      }
    }
  __syncthreads();
#pragma unroll 2
  for (int i = 0; i < 8; ++i) {
    int c = tid + 256 * i;
    int row = c >> 4, cc = (c & 15) * 8;
    *(half8*)(P.sg() + (size_t)(m0 + row) * 512 + n0 + cc) = *(const half8*)(cs + row * CS_STRIDE + cc);
  }
}

template <int WHICH>
__device__ __forceinline__ void g24_tile(const Params& P, int mt, int nt, char* smem) {
  const int tid = fresh_tid(), lane = tid & 63, wave = tid >> 6;
  const int wm = wave >> 1, wn = wave & 1;
  const int m0 = mt * 128, n0 = nt * 128;
  f32x16 acc[2][2];
#pragma unroll
  for (int a = 0; a < 2; ++a)
#pragma unroll
    for (int b = 0; b < 2; ++b)
#pragma unroll
      for (int i = 0; i < 16; ++i) acc[a][b][i] = 0.f;
  if (WHICH == 0) gemm_loop(P.attg(), 1024, P.wt_att(), 1024, 1024, m0, n0, acc, smem);
  else            gemm_loop(P.sg(), 512, P.wt_ssm(), 512, 512, m0, n0, acc, smem);
  half_t* cs = (half_t*)smem;
#pragma unroll 1
  for (int i = 0; i < 8; ++i) {
    const int c = tid + 256 * i;
    const int row = c >> 4, cc = (c & 15) * 8;
    const half8 gv = *(const half8*)(P.proj() + (size_t)(m0 + row) * NP + C_MG + WHICH * 2048 + n0 + cc);
    const f32x4 ba = *(const f32x4*)(P.b_merge + WHICH * 2048 + n0 + cc), bb4 = *(const f32x4*)(P.b_merge + WHICH * 2048 + n0 + cc + 4);
    asm volatile("" ::: "memory");
    half8 r;
#pragma unroll
    for (int j = 0; j < 8; ++j) r[j] = (half_t)sigmoidf_((float)gv[j] + (j < 4 ? ba[j & 3] : bb4[j & 3]));
    *(half8*)(cs + row * CS_STRIDE + cc) = r;
  }
  __syncthreads();
  half_t* csw = cs + (wm * 64 + 4 * (lane >> 5)) * CS_STRIDE + wn * 64 + (lane & 31);
#pragma unroll
  for (int a = 0; a < 2; ++a)
#pragma unroll
    for (int b = 0; b < 2; ++b) {
#pragma unroll
      for (int i = 0; i < 16; ++i) {
        const int o = (a * 32 + (i & 3) + 8 * (i >> 2)) * CS_STRIDE + b * 32;
        csw[o] = (half_t)(acc[a][b][i] * (float)csw[o]);
      }
      asm volatile("" ::: "memory");
    }
  __syncthreads();
  half_t* mixed = P.h();
#pragma unroll 2
  for (int i = 0; i < 8; ++i) {
    int c = tid + 256 * i;
    int row = c >> 4, cc = (c & 15) * 8;
    half8 v = *(const half8*)(cs + row * CS_STRIDE + cc);
    half_t* dst = mixed + (size_t)(m0 + row) * D + n0 + cc;
    if (WHICH == 1) {
      const half8 pv = *(const half8*)dst;
#pragma unroll
      for (int j = 0; j < 8; ++j) v[j] = (half_t)((float)v[j] + (float)pv[j]);
    }
    *(half8*)dst = v;
  }
}

__device__ __forceinline__ void g5_tile(const Params& P, int mt, int nt, char* smem) {
  const int tid = fresh_tid(), lane = tid & 63, wave = tid >> 6;
  const int wm = wave >> 1, wn = wave & 1;
  const int m0 = mt * 128, n0 = nt * 128;
  f32x16 acc[2][2];
#pragma unroll
  for (int a = 0; a < 2; ++a)
#pragma unroll
    for (int b = 0; b < 2; ++b)
#pragma unroll
      for (int i = 0; i < 16; ++i) acc[a][b][i] = 0.f;
  gemm_loop(P.h(), D, P.wt_out(), D, D, m0, n0, acc, smem);
#pragma unroll
  for (int a = 0; a < 2; ++a)
#pragma unroll
    for (int b = 0; b < 2; ++b) {
      const int n = n0 + ACC_COL(b);
      float xv[16];
#pragma unroll
      for (int i = 0; i < 16; ++i) xv[i] = P.x[(size_t)(m0 + ACC_ROW(a, i)) * D + n];
      asm volatile("" ::: "memory");
#pragma unroll
      for (int i = 0; i < 16; ++i) P.out[(size_t)(m0 + ACC_ROW(a, i)) * D + n] = xv[i] + acc[a][b][i];
    }
}

__device__ __forceinline__ void fn_task(const Params& P, int t) {
  const int tid = fresh_tid(), lane = tid & 63, wave = tid >> 6;
  int row = t * 4 + wave;
  float4* xr = (float4*)(P.out + (size_t)row * D);
  float4 v[8]; float ss = 0.f;
#pragma unroll
  for (int j = 0; j < 8; ++j) { v[j] = xr[j * 64 + lane]; ss += v[j].x * v[j].x + v[j].y * v[j].y + v[j].z * v[j].z + v[j].w * v[j].w; }
  ss = wave_sum(ss);
  float sc = rsqrtf(ss * (1.0f / D) + 1e-6f);
  const float4* g4 = (const float4*)P.g_final;
#pragma unroll
  for (int j = 0; j < 8; ++j) {
    float4 g = g4[j * 64 + lane];
    float4 o; o.x = v[j].x * sc * g.x; o.y = v[j].y * sc * g.y; o.z = v[j].z * sc * g.z; o.w = v[j].w * sc * g.w;
    xr[j * 64 + lane] = o;
  }
}

__device__ __forceinline__ void ssm_local(const Params& P, int item, char* smem, bool final_pass) {
  const int tid = fresh_tid(), lane = tid & 63, wave = tid >> 6;
  const int it = item * 4 + wave;
  const int n = it >> 5, g = it & 31;
  half_t* ub = (half_t*)(smem + wave * 2048);
  half_t* xs = (half_t*)(smem + 8192 + wave * 8192);
  __syncthreads();
  {
    const u32x4* src = (const u32x4*)(P.proj() + (size_t)(n * 64 + lane) * NP + C_U + g * 16);
    u32x4 u0 = src[0], u1 = src[1];
    *(u32x4*)(ub + lane * 16) = u0;
    *(u32x4*)(ub + lane * 16 + 8) = u1;
  }
  const int gp = g * 64 + lane;
  float bre[16], bim[16];
  {
    const float4* b4 = (const float4*)(P.bb() + (size_t)gp * 32);
#pragma unroll
    for (int j = 0; j < 4; ++j) { float4 v = b4[j]; bre[4 * j] = v.x; bre[4 * j + 1] = v.y; bre[4 * j + 2] = v.z; bre[4 * j + 3] = v.w; }
#pragma unroll
    for (int j = 0; j < 4; ++j) { float4 v = b4[4 + j]; bim[4 * j] = v.x; bim[4 * j + 1] = v.y; bim[4 * j + 2] = v.z; bim[4 * j + 3] = v.w; }
  }
  const float lr = P.lam()[gp * 2], li = P.lam()[gp * 2 + 1];
  float xr = 0.f, xi = 0.f;
  if (final_pass) { xr = P.E()[((size_t)n * 2048 + gp) * 2]; xi = P.E()[((size_t)n * 2048 + gp) * 2 + 1]; }
  __syncthreads();
  half8 bf[4];
  float dsk = 0.f;
  if (final_pass) {
#pragma unroll
    for (int ks = 0; ks < 4; ++ks)
      bf[ks] = *(const half8*)(P.cmT() + (size_t)(g * 16 + (lane & 15)) * 128 + ks * 32 + (lane >> 4) * 8);
    dsk = P.ssm_d[g * 16 + (lane & 15)];
  }
#pragma unroll 1
  for (int hb = 0; hb < 2; ++hb) {
#pragma unroll 2
    for (int tl = 0; tl < 32; ++tl) {
      const int tk = hb * 32 + tl;
      half8 ua = *(const half8*)(ub + tk * 16);
      half8 uc = *(const half8*)(ub + tk * 16 + 8);
      float br = 0.f, bi = 0.f;
#pragma unroll
      for (int c = 0; c < 8; ++c) { float uv = (float)ua[c]; br += bre[c] * uv; bi += bim[c] * uv; }
#pragma unroll
      for (int c = 0; c < 8; ++c) { float uv = (float)uc[c]; br += bre[8 + c] * uv; bi += bim[8 + c] * uv; }
      float nr = lr * xr - li * xi + br;
      float ni = lr * xi + li * xr + bi;
      xr = nr; xi = ni;
      if (final_pass) {
        xs[tl * 128 + lane] = (half_t)xr;
        xs[tl * 128 + 64 + lane] = (half_t)xi;
      }
    }
    if (final_pass) {
#pragma unroll
      for (int rt = 0; rt < 2; ++rt) {
        f32x4 y = {0.f, 0.f, 0.f, 0.f};
#pragma unroll
        for (int ks = 0; ks < 4; ++ks) {
          half8 af = *(const half8*)(xs + (rt * 16 + (lane & 15)) * 128 + ks * 32 + (lane >> 4) * 8);
          y = __builtin_amdgcn_mfma_f32_16x16x32_f16(af, bf[ks], y, 0, 0, 0);
        }
#pragma unroll
        for (int i = 0; i < 4; ++i) {
          int tk = hb * 32 + rt * 16 + (lane >> 4) * 4 + i;
          float uv = (float)ub[tk * 16 + (lane & 15)];
          float yv = y[i] + dsk * uv;
          P.s1()[(size_t)(n * 64 + tk) * 512 + g * 16 + (lane & 15)] = (half_t)gelu_tanh(yv);
        }
      }
    }
  }
  if (!final_pass) {
    P.E()[((size_t)n * 2048 + gp) * 2] = xr;
    P.E()[((size_t)n * 2048 + gp) * 2 + 1] = xi;
  }
}

__device__ __forceinline__ void ssm_carry(const Params& P, int blk) {
  const int gp = blk * 256 + fresh_tid();
  float lr = P.lam()[gp * 2], li = P.lam()[gp * 2 + 1];
#pragma unroll
  for (int s = 0; s < 6; ++s) { float nr = lr * lr - li * li; float ni = 2.0f * lr * li; lr = nr; li = ni; }
  float sr = 0.f, si = 0.f;
  float2* Ep = (float2*)P.E();
  for (int n0 = 0; n0 < 256; n0 += 32) {
    float2 e[32];
#pragma unroll
    for (int u = 0; u < 32; ++u) e[u] = Ep[(size_t)(n0 + u) * 2048 + gp];
    asm volatile("" ::: "memory");
#pragma unroll
    for (int u = 0; u < 32; ++u) {
      Ep[(size_t)(n0 + u) * 2048 + gp] = make_float2(sr, si);
      float nr = lr * sr - li * si + e[u].x;
      float ni = lr * si + li * sr + e[u].y;
      sr = nr; si = ni;
    }
  }
}

constexpr int QROW = 2080;

__device__ __forceinline__ void idx_score_item(const Params& P, int band, int item, char* smem) {
  const int tid = fresh_tid(), lane = tid & 63, wave = tid >> 6;
  const int nqt = band_rows(band) >> 4;
  const int qt = item % nqt, piece = item / nqt;
  const int q0 = band_q0(band) + qt * 16;
  const int sstride = band_stride(band);
  const int nadm = 64 * ((q0 >> 6) + 1);
  const int k0 = piece * KP;
  if (k0 >= nadm) return;
  const int kend = min(k0 + KP, nadm);
  __syncthreads();
  {
    u32x4 qv[8];
#pragma unroll
    for (int i = 0; i < 8; ++i) {
      const int c = tid + 256 * i;
      qv[i] = *(const u32x4*)(P.proj() + (size_t)(q0 + (c >> 7)) * NP + C_QI + (c & 127) * 8);
    }
    asm volatile("" ::: "memory");
#pragma unroll
    for (int i = 0; i < 8; ++i) {
      const int c = tid + 256 * i;
      *(u32x4*)(smem + (c >> 7) * QROW + (c & 127) * 16) = qv[i];
    }
  }
  float* wl = (float*)(smem + 16 * QROW);
  if (tid < 32) {
    const half8 wv = *(const half8*)(P.proj() + (size_t)(q0 + (tid & 15)) * NP + C_WI + (tid >> 4) * 8);
#pragma unroll
    for (int j = 0; j < 8; ++j) wl[((tid >> 4) * 8 + j) * 16 + (tid & 15)] = (float)wv[j];
  }
  __syncthreads();
  const int rt0 = qt * 16, spl = band_split(band);
  float* Sb = (rt0 < spl) ? (P.out + (size_t)rt0 * sstride) : ((float*)P.h() + (size_t)(rt0 - spl) * sstride);
  const char* qbase = smem + (lane & 15) * QROW + (lane >> 4) * 16;
  for (int slab = k0 + wave * 64; slab < kend; slab += 256) {
    half8 kf[4][2];
#pragma unroll
    for (int st = 0; st < 4; ++st)
#pragma unroll
      for (int ks = 0; ks < 2; ++ks)
        kf[st][ks] = *(const half8*)(P.kidx() + (size_t)(slab + st * 16 + (lane & 15)) * 64 + ks * 32 + (lane >> 4) * 8);
    f32x4 acc[4];
#pragma unroll
    for (int st = 0; st < 4; ++st) acc[st] = f32x4{0.f, 0.f, 0.f, 0.f};
#pragma unroll 2
    for (int h = 0; h < 16; ++h) {
      const float wh = wl[h * 16 + (lane & 15)];
      const half8 q0f = *(const half8*)(qbase + h * 128);
      const half8 q1f = *(const half8*)(qbase + h * 128 + 64);
      f32x4 lg[4];
#pragma unroll
      for (int st = 0; st < 4; ++st) {
        lg[st] = f32x4{0.f, 0.f, 0.f, 0.f};
        lg[st] = __builtin_amdgcn_mfma_f32_16x16x32_f16(kf[st][0], q0f, lg[st], 0, 0, 0);
        lg[st] = __builtin_amdgcn_mfma_f32_16x16x32_f16(kf[st][1], q1f, lg[st], 0, 0, 0);
      }
#pragma unroll
      for (int st = 0; st < 4; ++st)
#pragma unroll
        for (int i = 0; i < 4; ++i) {
          float rl = __int_as_float(max(__float_as_int(lg[st][i]), 0));
          asm("" : "+v"(rl));
          acc[st][i] = __builtin_fmaf(rl, wh, acc[st][i]);
        }
    }
    float* srow = Sb + (size_t)(lane & 15) * sstride + slab + 4 * (lane >> 4);
#pragma unroll
    for (int st = 0; st < 4; ++st) *(f32x4*)(srow + st * 16) = acc[st];
  }
}

__device__ __forceinline__ unsigned mono_key(float f) {
  unsigned u = __float_as_uint(f);
  return (u & 0x80000000u) ? ~u : (u | 0x80000000u);
}

__device__ __forceinline__ int wave_scan_add_i(int v) {
  v += __builtin_amdgcn_update_dpp(0, v, 0x111, 0xf, 0xf, true);
  v += __builtin_amdgcn_update_dpp(0, v, 0x112, 0xf, 0xf, true);
  v += __builtin_amdgcn_update_dpp(0, v, 0x114, 0xf, 0xf, true);
  v += __builtin_amdgcn_update_dpp(0, v, 0x118, 0xf, 0xf, true);
  v += __builtin_amdgcn_update_dpp(0, v, 0x142, 0xa, 0xf, false);
  v += __builtin_amdgcn_update_dpp(0, v, 0x143, 0xc, 0xf, false);
  return v;
}

template <int NV, int R>
__device__ __forceinline__ void select_rows(const float* __restrict__ S0, int sstride, int n, unsigned short* __restrict__ sel0,
                                            int* red, int tid, int lane, int wave) {
  unsigned v[R][NV];
#pragma unroll
  for (int r = 0; r < R; ++r)
#pragma unroll
    for (int j = 0; j < NV; ++j)
      v[r][j] = __float_as_uint(S0[(size_t)r * sstride + j * 256 + tid]);
  asm volatile("" ::: "memory");
#pragma unroll
  for (int r = 0; r < R; ++r)
#pragma unroll
    for (int j = 0; j < NV; ++j) {
      const unsigned u = v[r][j];
      const unsigned k = (u & 0x80000000u) ? ~u : (u | 0x80000000u);
      v[r][j] = (j * 256 + tid < n) ? k : 0u;
    }
  unsigned T[R], thr[R]; bool done[R];
#pragma unroll
  for (int r = 0; r < R; ++r) { T[r] = 0u; thr[r] = 0u; done[r] = false; }
  for (int bit = 31; bit >= 0; --bit) {
    int* slot = red + ((bit & 1) << 4);
#pragma unroll
    for (int r = 0; r < R; ++r) {
      if (!done[r]) {
        const unsigned cand = T[r] | (1u << bit);
        int cnt = 0;
#pragma unroll
        for (int j = 0; j < NV; ++j) cnt += (v[r][j] >= cand) ? 1 : 0;
        cnt = wave_scan_add_i(cnt);
        if (lane == 63) slot[r * 4 + wave] = cnt;
      }
    }
    __syncthreads();
    bool all_done = true;
#pragma unroll
    for (int r = 0; r < R; ++r) {
      if (!done[r]) {
        const int total = slot[r * 4] + slot[r * 4 + 1] + slot[r * 4 + 2] + slot[r * 4 + 3];
        if (total >= 256) { T[r] |= (1u << bit); if (total == 256) { done[r] = true; thr[r] = T[r]; } }
      }
      all_done = all_done && done[r];
    }
    if (all_done) break;
  }
  const unsigned long long lt = (lane == 0) ? 0ull : (~0ull >> (64 - lane));
  int* pre = red + 32;
#pragma unroll
  for (int r = 0; r < R; ++r) {
    const bool exact = done[r];
    const unsigned th = exact ? thr[r] : (T[r] + 1u);
    int cl = 0;
#pragma unroll
    for (int j = 0; j < NV; ++j) cl += (v[r][j] >= th) ? 1 : 0;
    const int incl = wave_scan_add_i(cl);
    const int wtot = __builtin_amdgcn_readlane(incl, 63);
    __syncthreads();
    if (lane == 0) pre[wave] = wtot;
    __syncthreads();
    int base = incl - cl, tot = 0;
#pragma unroll
    for (int w2 = 0; w2 < 4; ++w2) { int c = pre[w2]; if (w2 < wave) base += c; tot += c; }
    unsigned short* selq = sel0 + (size_t)r * 256;
#pragma unroll
    for (int j = 0; j < NV; ++j) {
      if (v[r][j] >= th) { selq[base] = (unsigned short)(j * 256 + tid); ++base; }
    }
    if (!exact && wave == 0) {
      const int need_eq = 256 - tot;
      const float* S = S0 + (size_t)r * sstride;
      int filled = 0;
      for (int i0 = 0; i0 < n && filled < need_eq; i0 += 64) {
        const unsigned key = mono_key(S[i0 + lane]);
        const bool e = (key == T[r]);
        const unsigned long long m = __ballot(e);
        const int pos = filled + __popcll(m & lt);
        if (e && pos < need_eq) selq[tot + pos] = (unsigned short)(i0 + lane);
        filled += __popcll(m);
      }
    }
  }
}

__device__ __forceinline__ void idx_select_group(const Params& P, int band, int grp, char* smem) {
  const int tid = fresh_tid(), lane = tid & 63, wave = tid >> 6;
  const int r0 = grp * 4;
  const int q0 = band_q0(band) + r0;
  const int sstride = band_stride(band);
  const int n = 64 * ((q0 >> 6) + 1);
  unsigned short* sel0 = P.sel() + (size_t)q0 * 256;
  if (n <= 256) {
#pragma unroll
    for (int r = 0; r < 4; ++r) sel0[r * 256 + tid] = (unsigned short)(tid < n ? tid : 0);
    return;
  }
  int* red = (int*)smem;
  const int spl = band_split(band);
  const float* S0 = (r0 < spl) ? (P.out + (size_t)r0 * sstride) : ((const float*)P.h() + (size_t)(r0 - spl) * sstride);
  const int nfull = (n + 255) >> 8;
  if (nfull <= 8) select_rows<8, 4>(S0, sstride, n, sel0, red, tid, lane, wave);
  else if (nfull <= 16) select_rows<16, 4>(S0, sstride, n, sel0, red, tid, lane, wave);
  else if (nfull <= 24) {
    select_rows<24, 2>(S0, sstride, n, sel0, red, tid, lane, wave);
    __syncthreads();
    select_rows<24, 2>(S0 + 2 * (size_t)sstride, sstride, n, sel0 + 512, red, tid, lane, wave);
  } else if (nfull <= 32) {
    select_rows<32, 2>(S0, sstride, n, sel0, red, tid, lane, wave);
    __syncthreads();
    select_rows<32, 2>(S0 + 2 * (size_t)sstride, sstride, n, sel0 + 512, red, tid, lane, wave);
  } else if (nfull <= 48) {
#pragma unroll 1
    for (int r = 0; r < 4; ++r) {
      select_rows<48, 1>(S0 + r * (size_t)sstride, sstride, n, sel0 + r * 256, red, tid, lane, wave);
      __syncthreads();
    }
  } else {
#pragma unroll 1
    for (int r = 0; r < 4; ++r) {
      select_rows<64, 1>(S0 + r * (size_t)sstride, sstride, n, sel0 + r * 256, red, tid, lane, wave);
      __syncthreads();
    }
  }
}

__device__ __forceinline__ void attn_item(const Params& P, int item, char* smem) {
  const int tid = fresh_tid(), lane = tid & 63, wave = tid >> 6;
  const int gw = item * 4 + wave;
  const int q = gw >> 1, kvh = gw & 1;
  const int nsel = min(256, 64 * ((q >> 6) + 1));
  char* wsm = smem + wave * 6144;
  unsigned short* sidx = (unsigned short*)wsm;
  float* pbuf = (float*)(wsm + 512);
  float* psum = (float*)(wsm + 512 + 4096);
  __syncthreads();
  *(uint2*)(sidx + lane * 4) = *(const uint2*)(P.sel() + (size_t)q * 256 + lane * 4);
  const int hn = lane & 15, kg = lane >> 4;
  half8 qf[4];
#pragma unroll
  for (int ks = 0; ks < 4; ++ks) {
    half8 z = *(const half8*)(P.proj() + (size_t)q * NP + C_Q + (kvh * 4 + (hn & 3)) * 128 + ks * 32 + kg * 8);
    if (hn >= 4) {
#pragma unroll
      for (int j = 0; j < 8; ++j) z[j] = (half_t)0.f;
    }
    qf[ks] = z;
  }
  __syncthreads();
  const float scale = 0.08838834764831845f;
  float mx = -INFINITY;
#pragma unroll
  for (int tg = 0; tg < 8; ++tg) {
    half8 kf[2][4];
#pragma unroll
    for (int t = 0; t < 2; ++t) {
      const int idx = sidx[(tg * 2 + t) * 16 + hn];
      const half_t* kp = P.proj() + (size_t)idx * NP + C_K + kvh * 128 + kg * 8;
#pragma unroll
      for (int ks = 0; ks < 4; ++ks) kf[t][ks] = *(const half8*)(kp + ks * 32);
    }
    asm volatile("" ::: "memory");
#pragma unroll
    for (int t = 0; t < 2; ++t) {
      f32x4 sv = {0.f, 0.f, 0.f, 0.f};
#pragma unroll
      for (int ks = 0; ks < 4; ++ks) sv = __builtin_amdgcn_mfma_f32_16x16x32_f16(kf[t][ks], qf[ks], sv, 0, 0, 0);
#pragma unroll
      for (int i = 0; i < 4; ++i) {
        const int slot = (tg * 2 + t) * 16 + kg * 4 + i;
        const float x = (slot < nsel) ? sv[i] * scale : -INFINITY;
        mx = fmaxf(mx, x);
        if (hn < 4) pbuf[slot * 4 + hn] = x;
      }
    }
  }
  mx = fmaxf(mx, __shfl_xor(mx, 16, 64));
  mx = fmaxf(mx, __shfl_xor(mx, 32, 64));
  float sum = 0.f;
  if (hn < 4) {
#pragma unroll 4
    for (int t = 0; t < 16; ++t)
#pragma unroll
      for (int i = 0; i < 4; ++i) {
        const int slot = t * 16 + kg * 4 + i;
        const float p = __expf(pbuf[slot * 4 + hn] - mx);
        sum += p;
        pbuf[slot * 4 + hn] = p;
      }
  }
  sum += __shfl_xor(sum, 16, 64);
  sum += __shfl_xor(sum, 32, 64);
  if (lane < 4) psum[lane] = sum;
  __syncthreads();
  float o[4][8];
#pragma unroll
  for (int h = 0; h < 4; ++h)
#pragma unroll
    for (int d = 0; d < 8; ++d) o[h][d] = 0.f;
  const half_t* vbase = P.proj() + C_V + kvh * 128 + hn * 8;
  const int nq = nsel >> 2;
  for (int i0 = 0; i0 < nq; i0 += 4) {
    half8 vv[4];
#pragma unroll
    for (int u = 0; u < 4; ++u) {
      const int idx = sidx[4 * (i0 + u) + kg];
      vv[u] = *(const half8*)(vbase + (size_t)idx * NP);
    }
    asm volatile("" ::: "memory");
#pragma unroll
    for (int u = 0; u < 4; ++u) {
      const float4 p4 = *(const float4*)(pbuf + (4 * (i0 + u) + kg) * 4);
#pragma unroll
      for (int d = 0; d < 8; ++d) {
        const float vf = (float)vv[u][d];
        o[0][d] += p4.x * vf; o[1][d] += p4.y * vf; o[2][d] += p4.z * vf; o[3][d] += p4.w * vf;
      }
    }
  }
#pragma unroll
  for (int h = 0; h < 4; ++h)
#pragma unroll
    for (int d = 0; d < 8; ++d) {
      float v = o[h][d];
      v += __shfl_xor(v, 16, 64);
      v += __shfl_xor(v, 32, 64);
      o[h][d] = v;
    }
  {
    const int h = kg;
    const float inv = 1.0f / psum[h];
    const int col = (kvh * 4 + h) * 128 + hn * 8;
    const half8 gt = *(const half8*)(P.proj() + (size_t)q * NP + C_AG + col);
    half8 r;
#pragma unroll
    for (int d = 0; d < 8; ++d) {
      const float ov = (h == 0) ? o[0][d] : (h == 1) ? o[1][d] : (h == 2) ? o[2][d] : o[3][d];
      r[d] = (half_t)(ov * inv * siluf_((float)gt[d]));
    }
    *(half8*)(P.attg() + (size_t)q * 1024 + col) = r;
  }
}

#define FOR_TILES_XCD(NT, CALL)                                                          \
  for (int t = bid; t < 128 * (NT); t += nb) { int mt, nt; tile_coords(t, (NT), mt, nt); CALL; }

__device__ __forceinline__ void run_phase(const Params& P, int ph, char* smem) {
  const int nb = gridDim.x, bid = blockIdx.x;
  if (ph == 0) { for (int t = bid; t < T0_TOTAL; t += nb) prep_task(P, t, smem); }
  else if (ph == 1) { FOR_TILES_XCD(NP / 128, g1_tile(P, mt, nt, smem)) }
  else if (ph == 2) { for (int t = bid; t < 2048; t += nb) ssm_local(P, t, smem, false); }
  else if (ph == 3) { if (bid < 8) ssm_carry(P, bid); }
  else if (ph == 4) { for (int t = bid; t < 2048; t += nb) ssm_local(P, t, smem, true); }
  else if (ph == 5) { for (int t = bid; t < 128 * 4; t += nb) { int mt, nt; tile_coords(t, 4, mt, nt); g3_tile(P, mt, nt, smem); } }
  else if (ph < 22) {
    const int b = (ph - 6) >> 1;
    if (((ph - 6) & 1) == 0) {
      const int nitems = 128 * ((BAND * (b + 1)) / KP);
      for (int t = bid; t < nitems; t += nb) idx_score_item(P, b, t, smem);
    } else {
      for (int t = bid; t < BAND / 4; t += nb) { __syncthreads(); idx_select_group(P, b, t, smem); }
    }
  }
  else if (ph == 22) { for (int t = bid; t < L * 2 / 4; t += nb) attn_item(P, t, smem); }
  else if (ph == 23) { FOR_TILES_XCD(16, { g24_tile<0>(P, mt, nt, smem); g24_tile<1>(P, mt, nt, smem); }) }
  else if (ph == 24) { FOR_TILES_XCD(16, g5_tile(P, mt, nt, smem)) }
  else if (ph == 25) { for (int t = bid; t < L / 4; t += nb) fn_task(P, t); }
}

#if !MEGA
template <int PH>
__global__ void __launch_bounds__(256, 3) k_ph(Params P) {
  __shared__ __attribute__((aligned(16))) char smem[SMEM_BYTES];
  run_phase(P, PH, smem);
}
__global__ void __launch_bounds__(256, 3) k_score(Params P, int b) {
  __shared__ __attribute__((aligned(16))) char smem[SMEM_BYTES];
  const int nb = gridDim.x, bid = blockIdx.x;
  const int nitems = 128 * ((BAND * (b + 1)) / KP);
  for (int t = bid; t < nitems; t += nb) idx_score_item(P, b, t, smem);
}
__global__ void __launch_bounds__(256, 3) k_select(Params P, int b) {
  __shared__ __attribute__((aligned(16))) char smem[SMEM_BYTES];
  const int nb = gridDim.x, bid = blockIdx.x;
  for (int t = bid; t < BAND / 4; t += nb) { __syncthreads(); idx_select_group(P, b, t, smem); }
}

#endif
#if MEGA
__global__ void __launch_bounds__(256, 3) k_mega(Params P) {
  __shared__ __attribute__((aligned(16))) char smem[SMEM_BYTES];
  cg::grid_group grid = cg::this_grid();
  __shared__ uint4 xb_words;
  if (threadIdx.x == 0) xb_words = make_uint4(0u, 0u, 0u, 0u);
  __syncthreads();
  XcdBarrier xb = xcd_barrier_post(P.bar(), (volatile LAS unsigned*)&xb_words);
  if (P.out == nullptr) grid.sync();
  const int nb = gridDim.x, bid = blockIdx.x;
  for (int r = 0; r < REP_P0; ++r) { run_phase(P, 0, smem); xcd_barrier(xb); }
  for (int r = 0; r < REP_G1; ++r) { run_phase(P, 1, smem); xcd_barrier(xb); }
  for (int b = 0; b < NBAND; ++b) {
    {
      const int n_sc = (band_rows(b) >> 4) * ((band_q0(b) + band_rows(b) + KP - 1) / KP);
      const int n_ex = (b == 0 || b == 1) ? 2048 : (b == 2 ? 512 : 0);
      const int n_at = (b >= 1) ? (band_rows(b - 1) * 2 / 4) : 0;
      const int at0 = (b >= 1) ? (band_q0(b - 1) * 2 / 4) : 0;
      for (int t = bid; t < n_sc; t += nb) idx_score_item(P, b, t, smem);
      const int r1 = (bid + nb - (n_sc % nb)) % nb;
      if (b == 0) { for (int u = r1; u < n_ex; u += nb) ssm_local(P, u, smem, false); }
      else if (b == 1) { for (int u = r1; u < n_ex; u += nb) ssm_local(P, u, smem, true); }
      else if (b == 2) { for (int u = r1; u < n_ex; u += nb) { int mt, nt; tile_coords(u, 4, mt, nt); g3_tile(P, mt, nt, smem); } }
      const int r2 = (r1 + nb - (n_ex % nb)) % nb;
      for (int u = r2; u < n_at; u += nb) attn_item(P, at0 + u, smem);
    }
    xcd_barrier(xb);
    if (b == 0 && bid >= nb - 8) ssm_carry(P, bid - (nb - 8));
    else for (int t = bid; t < band_rows(b) / 4; t += (b == 0 ? nb - 8 : nb)) { __syncthreads(); idx_select_group(P, b, t, smem); }
    xcd_barrier(xb);
  }
  for (int t = bid; t < band_rows(NBAND - 1) * 2 / 4; t += nb) attn_item(P, band_q0(NBAND - 1) * 2 / 4 + t, smem);
  xcd_barrier(xb);
  run_phase(P, 23, smem); xcd_barrier(xb);
  for (int r = 0; r < REP_G5; ++r) { run_phase(P, 24, smem); xcd_barrier(xb); }
  run_phase(P, 25, smem);
}
#endif

extern "C" void kernel_launch(void* const* d_in, const int* in_sizes, int n_in, void* d_out, int out_size,
                              void* d_ws, size_t ws_size, hipStream_t stream) {
  Params p{};
  p.x = (const float*)d_in[0]; p.pos = (const int*)d_in[1]; p.g_norm = (const float*)d_in[2];
  p.w_in = (const float*)d_in[3]; p.b_merge = (const float*)d_in[4]; p.a_re = (const float*)d_in[5];
  p.a_im = (const float*)d_in[6]; p.log_dt = (const float*)d_in[7]; p.b_re = (const float*)d_in[8];
  p.b_im = (const float*)d_in[9]; p.c_re = (const float*)d_in[10]; p.c_im = (const float*)d_in[11];
  p.ssm_d = (const float*)d_in[12]; p.w_glu = (const float*)d_in[13]; p.b_glu = (const float*)d_in[14];
  p.w_att_out = (const float*)d_in[15]; p.w_ssm_out = (const float*)d_in[16]; p.w_out = (const float*)d_in[17];
  p.g_final = (const float*)d_in[18];
  p.out = (float*)d_out;
  p.ws = (char*)d_ws;
  size_t off = WS_NEEDED;
  if (off > ws_size) { fprintf(stderr, "workspace too small: need %zu have %zu\n", off, ws_size); return; }
#if MEGA
  static int grid_blocks = 0;
  if (!grid_blocks) {
    int dev = 0, cus = 0, per_cu = 0;
    hipGetDevice(&dev);
    hipDeviceGetAttribute(&cus, hipDeviceAttributeMultiprocessorCount, dev);
    hipOccupancyMaxActiveBlocksPerMultiprocessor(&per_cu, k_mega, 256, 0);
    if (per_cu > 3) per_cu = 3;
    grid_blocks = cus * per_cu;
  }
  hipMemsetAsync(p.bar(), 0, XCD_BAR_WORDS * 4, stream);
  void* args[] = {&p};
  hipError_t e = hipLaunchCooperativeKernel((void*)k_mega, dim3(grid_blocks), dim3(256), args, 0, stream);
  if (e != hipSuccess) fprintf(stderr, "cooperative launch failed: %s (grid %d)\n", hipGetErrorString(e), grid_blocks);
#else
  k_ph<0><<<1024, 256, 0, stream>>>(p);
  k_ph<1><<<512, 256, 0, stream>>>(p);
  k_ph<2><<<512, 256, 0, stream>>>(p);
  k_ph<3><<<8, 256, 0, stream>>>(p);
  k_ph<4><<<512, 256, 0, stream>>>(p);
  k_ph<5><<<512, 256, 0, stream>>>(p);
  for (int b = 0; b < 8; ++b) { k_score<<<512, 256, 0, stream>>>(p, b); k_select<<<1024, 256, 0, stream>>>(p, b); }
  k_ph<22><<<1024, 256, 0, stream>>>(p);
  k_ph<23><<<512, 256, 0, stream>>>(p);
  k_ph<24><<<512, 256, 0, stream>>>(p);
  k_ph<25><<<1024, 256, 0, stream>>>(p);
#endif
}
```

```cpp
#include <hip/hip_runtime.h>
#include <hip/hip_cooperative_groups.h>
#include <stdint.h>
#include <stdio.h>
namespace cg = cooperative_groups;

#ifndef MEGA
#define MEGA 1
#endif
#ifndef REP_G1
#define REP_G1 1
#endif
#ifndef REP_SC
#define REP_SC 1
#endif
#ifndef REP_SEL
#define REP_SEL 1
#endif
#ifndef REP_ATT
#define REP_ATT 1
#endif
#ifndef REP_SSM
#define REP_SSM 1
#endif
#ifndef REP_G24
#define REP_G24 1
#endif
#ifndef REP_P0
#define REP_P0 1
#endif
#ifndef REP_S3
#define REP_S3 1
#endif
#ifndef REP_G3
#define REP_G3 1
#endif
#ifndef REP_G5
#define REP_G5 1
#endif

typedef _Float16 half_t;
typedef _Float16 half8 __attribute__((ext_vector_type(8)));
typedef _Float16 half4 __attribute__((ext_vector_type(4)));
typedef _Float16 half2v __attribute__((ext_vector_type(2)));
typedef float f32x16 __attribute__((ext_vector_type(16)));
typedef float f32x4 __attribute__((ext_vector_type(4)));
typedef unsigned int u32x4 __attribute__((ext_vector_type(4)));

constexpr int L = 16384, D = 2048, NIN = 8784, NP = 8832;
constexpr int C_Q = 0, C_K = 1024, C_V = 1280, C_AG = 1536, C_QI = 2560, C_KI = 3584, C_U = 3648,
              C_SG = 4160, C_MG = 4672, C_WI = 8768;
constexpr int SMEM_BYTES = 53248;
constexpr int BAND = 2048;
constexpr int NBAND = 4;
__device__ __host__ __forceinline__ constexpr int band_q0(int b) { return b == 0 ? 0 : b == 1 ? 6976 : b == 2 ? 11264 : b == 3 ? 14592 : 16384; }
__device__ __host__ __forceinline__ constexpr int band_rows(int b) { return band_q0(b + 1) - band_q0(b); }
__device__ __host__ __forceinline__ constexpr int band_stride(int b) { return band_q0(b + 1); }
__device__ __host__ __forceinline__ constexpr int band_split(int b) { return b == 0 ? 4800 : b == 1 ? 2976 : b == 2 ? 2288 : 1792; }
constexpr int KP = 1024;
constexpr int NPHASE = 26;

constexpr size_t al256(size_t x) { return (x + 255) & ~(size_t)255; }
constexpr size_t OFF_proj = 0;
constexpr size_t OFF_kidx = OFF_proj + al256((size_t)L * NP * 2);
constexpr size_t OFF_h = OFF_kidx + al256((size_t)L * 64 * 2);
constexpr size_t OFF_wt_in = OFF_h + al256((size_t)L * D * 2);
constexpr size_t OFF_wt_att = OFF_wt_in + al256((size_t)NP * D * 2);
constexpr size_t OFF_wt_glu = OFF_wt_att + al256((size_t)2048 * 1024 * 2);
constexpr size_t OFF_wt_ssm = OFF_wt_glu + al256((size_t)512 * 512 * 2);
constexpr size_t OFF_wt_out = OFF_wt_ssm + al256((size_t)2048 * 512 * 2);
constexpr size_t OFF_s1 = OFF_wt_out + al256((size_t)2048 * 2048 * 2);
constexpr size_t OFF_sg = OFF_s1 + al256((size_t)L * 512 * 2);
constexpr size_t OFF_attg = OFF_sg + al256((size_t)L * 512 * 2);
constexpr size_t OFF_cmT = OFF_attg + al256((size_t)L * 1024 * 2);
constexpr size_t OFF_cos128 = OFF_cmT + al256((size_t)32 * 16 * 128 * 2);
constexpr size_t OFF_sin128 = OFF_cos128 + al256((size_t)L * 16 * 4);
constexpr size_t OFF_cos64 = OFF_sin128 + al256((size_t)L * 16 * 4);
constexpr size_t OFF_sin64 = OFF_cos64 + al256((size_t)L * 8 * 4);
constexpr size_t OFF_lam = OFF_sin64 + al256((size_t)L * 8 * 4);
constexpr size_t OFF_bb = OFF_lam + al256((size_t)2048 * 2 * 4);
constexpr size_t OFF_E = OFF_bb + al256((size_t)2048 * 32 * 4);
constexpr size_t OFF_sel = OFF_E + al256((size_t)256 * 2048 * 2 * 4);
constexpr size_t OFF_bar = OFF_sel + al256((size_t)L * 256 * 2);
constexpr size_t WS_NEEDED = OFF_bar + al256((size_t)3456 * 4);
struct Params {
  const float* x; const int* pos; const float* g_norm; const float* w_in; const float* b_merge;
  const float* a_re; const float* a_im; const float* log_dt; const float* b_re; const float* b_im;
  const float* c_re; const float* c_im; const float* ssm_d; const float* w_glu; const float* b_glu;
  const float* w_att_out; const float* w_ssm_out; const float* w_out; const float* g_final;
  float* out;
  char* ws;
  __device__ __host__ __forceinline__ half_t* proj() const { return (half_t*)(ws + OFF_proj); }
  __device__ __host__ __forceinline__ half_t* kidx() const { return (half_t*)(ws + OFF_kidx); }
  __device__ __host__ __forceinline__ half_t* h() const { return (half_t*)(ws + OFF_h); }
  __device__ __host__ __forceinline__ half_t* wt_in() const { return (half_t*)(ws + OFF_wt_in); }
  __device__ __host__ __forceinline__ half_t* wt_att() const { return (half_t*)(ws + OFF_wt_att); }
  __device__ __host__ __forceinline__ half_t* wt_glu() const { return (half_t*)(ws + OFF_wt_glu); }
  __device__ __host__ __forceinline__ half_t* wt_ssm() const { return (half_t*)(ws + OFF_wt_ssm); }
  __device__ __host__ __forceinline__ half_t* wt_out() const { return (half_t*)(ws + OFF_wt_out); }
  __device__ __host__ __forceinline__ half_t* s1() const { return (half_t*)(ws + OFF_s1); }
  __device__ __host__ __forceinline__ half_t* sg() const { return (half_t*)(ws + OFF_sg); }
  __device__ __host__ __forceinline__ half_t* attg() const { return (half_t*)(ws + OFF_attg); }
  __device__ __host__ __forceinline__ half_t* cmT() const { return (half_t*)(ws + OFF_cmT); }
  __device__ __host__ __forceinline__ float* cos128() const { return (float*)(ws + OFF_cos128); }
  __device__ __host__ __forceinline__ float* sin128() const { return (float*)(ws + OFF_sin128); }
  __device__ __host__ __forceinline__ float* cos64() const { return (float*)(ws + OFF_cos64); }
  __device__ __host__ __forceinline__ float* sin64() const { return (float*)(ws + OFF_sin64); }
  __device__ __host__ __forceinline__ float* lam() const { return (float*)(ws + OFF_lam); }
  __device__ __host__ __forceinline__ float* bb() const { return (float*)(ws + OFF_bb); }
  __device__ __host__ __forceinline__ float* E() const { return (float*)(ws + OFF_E); }
  __device__ __host__ __forceinline__ unsigned short* sel() const { return (unsigned short*)(ws + OFF_sel); }
  __device__ __host__ __forceinline__ unsigned* bar() const { return (unsigned*)(ws + OFF_bar); }
};


#define XB_TMO      128
#define XB_XCNT(j)  (256  + 64 * (j))
#define XB_XSUB(j)  (1280 + 64 * (j))
#define XB_XGEN(j)  (2304 + 64 * (j))
#define XB_TOP      3328
#define XB_TOPGEN   3392
#define XCD_BAR_WORDS 3456
#define XB_SPIN_CAP (1u << 18)
#define LAS __attribute__((address_space(3)))

__device__ __forceinline__ unsigned xb_ld(unsigned* p)              { return __hip_atomic_load(p, __ATOMIC_RELAXED, __HIP_MEMORY_SCOPE_AGENT); }
__device__ __forceinline__ unsigned xb_add(unsigned* p, unsigned v) { return __hip_atomic_fetch_add(p, v, __ATOMIC_RELAXED, __HIP_MEMORY_SCOPE_AGENT); }
__device__ __forceinline__ unsigned xb_xcc_id() { return (unsigned)__builtin_amdgcn_s_getreg((3 << 11) | 20) & 0xFu; }
#define XB_SPIN(cond, bar) do { unsigned _sp = 0; while (cond) { __builtin_amdgcn_s_sleep(1); \
    if ((++_sp & 255u) == 0u) { if (xb_ld(&(bar)[XB_TMO])) break; if (_sp > XB_SPIN_CAP) { atomicAdd(&(bar)[XB_TMO], 1u); break; } } } } while (0)

struct XcdBarrier { unsigned* bar; unsigned x; volatile LAS unsigned* st; };

__device__ __forceinline__ XcdBarrier xcd_barrier_post(unsigned* bar, volatile LAS unsigned* st) {
    XcdBarrier b; b.bar = bar; b.x = xb_xcc_id(); b.st = st;
    if (threadIdx.x == 0) (void)xb_add(&bar[XB_XCNT(b.x)], 1u);
    return b;
}
__device__ __forceinline__ void xcd_barrier_complete(unsigned* bar, unsigned x, unsigned& nloc, unsigned& nx) {
    const unsigned G = gridDim.x * gridDim.y * gridDim.z;
    unsigned sum, cnt, mine, sp = 0u;
    for (;;) {
        sum = 0u; cnt = 0u; mine = 0u;
#pragma unroll
        for (unsigned j = 0; j < 16; ++j) { const unsigned c = xb_ld(&bar[XB_XCNT(j)]); sum += c; cnt += (c > 0u) ? 1u : 0u; mine = (j == x) ? c : mine; }
        if (sum == G) break;
        __builtin_amdgcn_s_sleep(1);
        if ((++sp & 255u) == 0u) { if (xb_ld(&bar[XB_TMO])) break; if (sp > XB_SPIN_CAP) { atomicAdd(&bar[XB_TMO], 1u); break; } }
    }
    nloc = mine > 0u ? mine : 1u; nx = cnt > 0u ? cnt : 1u;
}
__device__ __forceinline__ void xcd_barrier(const XcdBarrier& b) {
    asm volatile("s_waitcnt vmcnt(0)" ::: "memory");
    __syncthreads();
    if (threadIdx.x == 0) {
        unsigned* bar = b.bar;
        __builtin_amdgcn_s_waitcnt(0);
        unsigned nloc = b.st[0], nx = b.st[1];
        if (nloc == 0u) { xcd_barrier_complete(bar, b.x, nloc, nx); b.st[0] = nloc; b.st[1] = nx; }
        const unsigned old = xb_add(&bar[XB_XSUB(b.x)], 1u);
        const unsigned gen = old / nloc;
        if (old + 1u == (gen + 1u) * nloc) {
            __builtin_amdgcn_fence(__ATOMIC_RELEASE, "agent");
            asm volatile("s_waitcnt vmcnt(0)" ::: "memory");
            const unsigned og = xb_add(&bar[XB_TOP], 1u);
            const unsigned tg = og / nx;
            if (og + 1u == (tg + 1u) * nx) xb_add(&bar[XB_TOPGEN], 1u);
            else XB_SPIN(xb_ld(&bar[XB_TOPGEN]) == tg, bar);
            __builtin_amdgcn_fence(__ATOMIC_ACQUIRE, "agent");
            xb_add(&bar[XB_XGEN(b.x)], 1u);
            asm volatile("s_waitcnt vmcnt(0)" ::: "memory");
        } else {
            XB_SPIN(xb_ld(&bar[XB_XGEN(b.x)]) == gen, bar);
            __builtin_amdgcn_fence(__ATOMIC_ACQUIRE, "agent");
            asm volatile("s_waitcnt vmcnt(0)" ::: "memory");
        }
    }
    __syncthreads();
}

__device__ __forceinline__ int fresh_tid() { int t = threadIdx.x; asm volatile("" : "+v"(t)); return t; }
__device__ __forceinline__ float wave_sum(float v) {
#pragma unroll
  for (int o = 32; o > 0; o >>= 1) v += __shfl_xor(v, o, 64);
  return v;
}
__device__ __forceinline__ float sigmoidf_(float x) { return 1.0f / (1.0f + __expf(-x)); }
__device__ __forceinline__ float siluf_(float x) { return x / (1.0f + __expf(-x)); }
__device__ __forceinline__ float gelu_tanh(float x) {
  float u = 0.7978845608028654f * (x + 0.044715f * x * x * x);
  float t = 1.0f - 2.0f / (__expf(2.0f * u) + 1.0f);
  return 0.5f * x * (1.0f + t);
}

constexpr int T0_NORM = L / 4;
constexpr int T0_WIN = (D / 64) * (NP / 64);
constexpr int T0_WATT = (1024 / 64) * (2048 / 64);
constexpr int T0_WGLU = (512 / 64) * (512 / 64);
constexpr int T0_WSSM = (512 / 64) * (2048 / 64);
constexpr int T0_WOUT = (2048 / 64) * (2048 / 64);
constexpr int T0_ROT = (L * 24) / 256;
constexpr int T0_SSM = 8;
constexpr int T0_TOTAL = T0_NORM + T0_WIN + T0_WATT + T0_WGLU + T0_WSSM + T0_WOUT + T0_ROT + T0_SSM;

__device__ __forceinline__ int remap_col(int np) {
  if (np < 3648) return np;
  if (np < 8768) return np + 16;
  if (np < 8784) return np - 8768 + 3648;
  return -1;
}

__device__ __forceinline__ void transpose_tile(const float* __restrict__ W, int K, int N, half_t* __restrict__ Wt,
                               int kt, int nt, bool remap, char* smem) {
  half_t* t = (half_t*)smem;
  const int tid = fresh_tid();
  {
    const int nn = tid & 63;
    const int np = nt * 64 + nn;
    const int n = remap ? remap_col(np) : np;
    const int nc = n >= 0 ? n : 0;
    float wv[16];
#pragma unroll
    for (int i = 0; i < 16; ++i) wv[i] = W[(size_t)(kt * 64 + (tid >> 6) + 4 * i) * N + nc];
    asm volatile("" ::: "memory");
#pragma unroll
    for (int i = 0; i < 16; ++i) t[nn * 66 + (tid >> 6) + 4 * i] = (half_t)(n >= 0 ? wv[i] : 0.0f);
  }
  __syncthreads();
#pragma unroll 4
  for (int i = 0; i < 8; ++i) {
    int e = tid + 256 * i;
    int nn = e >> 5, kp = e & 31;
    half2v v; v.x = t[nn * 66 + kp * 2]; v.y = t[nn * 66 + kp * 2 + 1];
    *(half2v*)(Wt + (size_t)(nt * 64 + nn) * K + kt * 64 + kp * 2) = v;
  }
  __syncthreads();
}

__device__ __forceinline__ void prep_task(const Params& P, int t, char* smem) {
  const int tid = fresh_tid(), lane = tid & 63, wave = tid >> 6;
  if (t < T0_NORM) {
    int row = t * 4 + wave;
    const float4* xr = (const float4*)(P.x + (size_t)row * D);
    float4 v[8]; float ss = 0.f;
#pragma unroll
    for (int j = 0; j < 8; ++j) { v[j] = xr[j * 64 + lane]; ss += v[j].x * v[j].x + v[j].y * v[j].y + v[j].z * v[j].z + v[j].w * v[j].w; }
    ss = wave_sum(ss);
    float sc = rsqrtf(ss * (1.0f / D) + 1e-6f);
    const float4* g4 = (const float4*)P.g_norm;
#pragma unroll
    for (int j = 0; j < 8; ++j) {
      float4 g = g4[j * 64 + lane];
      half4 o; o.x = (half_t)(v[j].x * sc * g.x); o.y = (half_t)(v[j].y * sc * g.y);
      o.z = (half_t)(v[j].z * sc * g.z); o.w = (half_t)(v[j].w * sc * g.w);
      *(half4*)(P.h() + (size_t)row * D + (j * 64 + lane) * 4) = o;
    }
    return;
  }
  t -= T0_NORM;
  if (t < T0_WIN) { transpose_tile(P.w_in, D, NIN, P.wt_in(), t % 32, t / 32, true, smem); return; }
  t -= T0_WIN;
  if (t < T0_WATT) { transpose_tile(P.w_att_out, 1024, 2048, P.wt_att(), t % 16, t / 16, false, smem); return; }
  t -= T0_WATT;
  if (t < T0_WGLU) { transpose_tile(P.w_glu, 512, 512, P.wt_glu(), t % 8, t / 8, false, smem); return; }
  t -= T0_WGLU;
  if (t < T0_WSSM) { transpose_tile(P.w_ssm_out, 512, 2048, P.wt_ssm(), t % 8, t / 8, false, smem); return; }
  t -= T0_WSSM;
  if (t < T0_WOUT) { transpose_tile(P.w_out, 2048, 2048, P.wt_out(), t % 32, t / 32, false, smem); return; }
  t -= T0_WOUT;
  if (t < T0_ROT) {
    int e = t * 256 + tid;
    int tok = e / 24, i = e % 24;
    float a;
    if (i < 16) { a = (-13.122363377404328f) * (float)i; a = a * (2.0f / 32.0f); }
    else        { a = (-13.122363377404328f) * (float)(i - 16); a = a * (2.0f / 16.0f); }
    float inv = expf(a);
    float ang = (float)P.pos[tok] * inv;
    double rev = (double)ang * 0.15915494309189535;
    rev = rev - rint(rev);
    float fr = (float)rev;
    float s = __builtin_amdgcn_sinf(fr);
    float c = __builtin_amdgcn_cosf(fr);
    if (i < 16) { P.cos128()[tok * 16 + i] = c; P.sin128()[tok * 16 + i] = s; }
    else        { P.cos64()[tok * 8 + i - 16] = c; P.sin64()[tok * 8 + i - 16] = s; }
    return;
  }
  t -= T0_ROT;
  {
    int gp = t * 256 + tid;
    int g = gp >> 6, p = gp & 63;
    float dt = expf(P.log_dt[g]);
    float ar = P.a_re[gp], ai = P.a_im[gp];
    float mag = expf(ar * dt);
    float ang = ai * dt;
    double rev = (double)ang * 0.15915494309189535;
    rev = rev - rint(rev);
    float fr = (float)rev;
    float lr = mag * __builtin_amdgcn_cosf(fr);
    float li = mag * __builtin_amdgcn_sinf(fr);
    float den = ar * ar + ai * ai;
    float cr = ((lr - 1.0f) * ar + li * ai) / den;
    float ci = (li * ar - (lr - 1.0f) * ai) / den;
    P.lam()[gp * 2] = lr; P.lam()[gp * 2 + 1] = li;
    for (int c = 0; c < 16; ++c) {
      float br = P.b_re[gp * 16 + c], bi = P.b_im[gp * 16 + c];
      P.bb()[gp * 32 + c] = cr * br - ci * bi;
      P.bb()[gp * 32 + 16 + c] = cr * bi + ci * br;
      P.cmT()[(g * 16 + c) * 128 + p] = (half_t)P.c_re[(g * 16 + c) * 64 + p];
      P.cmT()[(g * 16 + c) * 128 + 64 + p] = (half_t)(-P.c_im[(g * 16 + c) * 64 + p]);
    }
  }
}

constexpr int LDS_ROW = 144;
constexpr int LDS_TILE = 128 * LDS_ROW;
constexpr int LDS_STAGE = 2 * LDS_TILE;

__device__ __forceinline__ void gemm_loop(const half_t* __restrict__ A, int lda, const half_t* __restrict__ B,
                                          int ldb, int K, int m0, int n0, f32x16 (&acc)[2][2], char* smem) {
  const int tid = fresh_tid(), lane = tid & 63, wave = tid >> 6;
  const int wm = wave >> 1, wn = wave & 1;
  const int lrow = tid >> 3, lkc = tid & 7;
  const half_t* ga = A + (size_t)(m0 + lrow) * lda + lkc * 8;
  const half_t* gb = B + (size_t)(n0 + lrow) * ldb + lkc * 8;
  u32x4 ra[4], rb[4];
  const int KT = K >> 6;
#pragma unroll
  for (int i = 0; i < 4; ++i) {
    ra[i] = *(const u32x4*)(ga + (size_t)(32 * i) * lda);
    rb[i] = *(const u32x4*)(gb + (size_t)(32 * i) * ldb);
  }
  const int arow = (wm * 64 + (lane & 31)) * LDS_ROW + (lane >> 5) * 16;
  const int brow = LDS_TILE + (wn * 64 + (lane & 31)) * LDS_ROW + (lane >> 5) * 16;
  for (int kt = 0; kt < KT; ++kt) {
    __syncthreads();
#pragma unroll
    for (int i = 0; i < 4; ++i) {
      *(u32x4*)(smem + (lrow + 32 * i) * LDS_ROW + lkc * 16) = ra[i];
      *(u32x4*)(smem + LDS_TILE + (lrow + 32 * i) * LDS_ROW + lkc * 16) = rb[i];
    }
    {
      const int kn = (kt + 1 < KT) ? kt + 1 : kt;
#pragma unroll
      for (int i = 0; i < 4; ++i) {
        ra[i] = *(const u32x4*)(ga + (size_t)(32 * i) * lda + kn * 64);
        rb[i] = *(const u32x4*)(gb + (size_t)(32 * i) * ldb + kn * 64);
      }
    }
    __syncthreads();
#pragma unroll
    for (int ks = 0; ks < 4; ++ks) {
      half8 a0 = *(const half8*)(smem + arow + ks * 32);
      half8 a1 = *(const half8*)(smem + arow + 32 * LDS_ROW + ks * 32);
      half8 b0 = *(const half8*)(smem + brow + ks * 32);
      half8 b1 = *(const half8*)(smem + brow + 32 * LDS_ROW + ks * 32);
      acc[0][0] = __builtin_amdgcn_mfma_f32_32x32x16_f16(a0, b0, acc[0][0], 0, 0, 0);
      acc[0][1] = __builtin_amdgcn_mfma_f32_32x32x16_f16(a0, b1, acc[0][1], 0, 0, 0);
      acc[1][0] = __builtin_amdgcn_mfma_f32_32x32x16_f16(a1, b0, acc[1][0], 0, 0, 0);
      acc[1][1] = __builtin_amdgcn_mfma_f32_32x32x16_f16(a1, b1, acc[1][1], 0, 0, 0);
      if (ks & 1) asm volatile("" ::: "memory");
    }
  }
  __builtin_amdgcn_sched_barrier(0);
  __syncthreads();
  __builtin_amdgcn_sched_barrier(0);
}

#define ACC_ROW(mt, i) (wm * 64 + (mt) * 32 + ((i) & 3) + 8 * ((i) >> 2) + 4 * (lane >> 5))
#define ACC_COL(nt) (wn * 64 + (nt) * 32 + (lane & 31))

constexpr int CS_STRIDE = 136;

__device__ __forceinline__ void tile_coords(int t, int NT, int& mt, int& nt) {
  int per = 16 * NT;
  int grp = t / per, r = t - grp * per;
  nt = r >> 4; mt = grp * 16 + (r & 15);
}

__device__ __forceinline__ void g1_tile(const Params& P, int mt, int nt, char* smem) {
  const int tid = fresh_tid(), lane = tid & 63, wave = tid >> 6;
  const int wm = wave >> 1, wn = wave & 1;
  const int m0 = mt * 128, n0 = nt * 128;
  f32x16 acc[2][2];
#pragma unroll
  for (int a = 0; a < 2; ++a)
#pragma unroll
    for (int b = 0; b < 2; ++b)
#pragma unroll
      for (int i = 0; i < 16; ++i) acc[a][b][i] = 0.f;
  gemm_loop(P.h(), D, P.wt_in(), D, D, m0, n0, acc, smem);
  half_t* cs = (half_t*)smem;
  half_t* csw = cs + (wm * 64 + 4 * (lane >> 5)) * CS_STRIDE + wn * 64 + (lane & 31);
#pragma unroll
  for (int a = 0; a < 2; ++a)
#pragma unroll
    for (int b = 0; b < 2; ++b) {
      const float sc = (n0 + ACC_COL(b) >= C_WI) ? (1.0f / 32.0f) : 1.0f;
#pragma unroll
      for (int i = 0; i < 16; ++i) csw[(a * 32 + (i & 3) + 8 * (i >> 2)) * CS_STRIDE + b * 32] = (half_t)(acc[a][b][i] * sc);
    }
  __syncthreads();
#pragma unroll 2
  for (int i = 0; i < 8; ++i) {
    int c = tid + 256 * i;
    int row = c >> 4, cc = (c & 15) * 8;
    int n = n0 + cc, m = m0 + row;
    half8 v = *(const half8*)(cs + row * CS_STRIDE + cc);
    if (n < C_V) {
      int d = n & 127;
      if (d < 32) {
        const bool lo = d < 16;
        half8 o = *(const half8*)(cs + row * CS_STRIDE + (lo ? cc + 16 : cc - 16));
        const int fi = lo ? d : d - 16;
        const float* cp = P.cos128() + (size_t)m * 16 + fi;
        const float* sp = P.sin128() + (size_t)m * 16 + fi;
        half8 r;
#pragma unroll
        for (int j = 0; j < 8; ++j) {
          float cv = cp[j], sv = sp[j];
          float x1 = lo ? (float)v[j] : (float)o[j];
          float x2 = lo ? (float)o[j] : (float)v[j];
          r[j] = (half_t)(lo ? (x1 * cv - x2 * sv) : (x2 * cv + x1 * sv));
        }
        v = r;
      }
    } else if (n >= C_QI && n < C_U) {
      int d = n & 63;
      if (d < 16) {
        const bool lo = d < 8;
        half8 o = *(const half8*)(cs + row * CS_STRIDE + (lo ? cc + 8 : cc - 8));
        const float* cp = P.cos64() + (size_t)m * 8;
        const float* sp = P.sin64() + (size_t)m * 8;
        half8 r;
#pragma unroll
        for (int j = 0; j < 8; ++j) {
          float cv = cp[j], sv = sp[j];
          float x1 = lo ? (float)v[j] : (float)o[j];
          float x2 = lo ? (float)o[j] : (float)v[j];
          r[j] = (half_t)(lo ? (x1 * cv - x2 * sv) : (x2 * cv + x1 * sv));
        }
        v = r;
      }
    }
    if (n >= C_KI && n < C_U) *(half8*)(P.kidx() + (size_t)m * 64 + (n - C_KI)) = v;
    else *(half8*)(P.proj() + (size_t)m * NP + n) = v;
  }
}

__device__ __forceinline__ void g3_tile(const Params& P, int mt, int nt, char* smem) {
  const int tid = fresh_tid(), lane = tid & 63, wave = tid >> 6;
  const int wm = wave >> 1, wn = wave & 1;
  const int m0 = mt * 128, n0 = nt * 128;
  f32x16 acc[2][2];
#pragma unroll
  for (int a = 0; a < 2; ++a)
#pragma unroll
    for (int b = 0; b < 2; ++b)
#pragma unroll
      for (int i = 0; i < 16; ++i) acc[a][b][i] = 0.f;
  gemm_loop(P.s1(), 512, P.wt_glu(), 512, 512, m0, n0, acc, smem);
  half_t* cs = (half_t*)smem;
  half_t* csw = cs + (wm * 64 + 4 * (lane >> 5)) * CS_STRIDE + wn * 64 + (lane & 31);
#pragma unroll
  for (int a = 0; a < 2; ++a)
#pragma unroll
    for (int b = 0; b < 2; ++b) {
      const int col = ACC_COL(b);
      const int n = n0 + col;
      const float bg = P.b_glu[n];
#pragma unroll
      for (int i0 = 0; i0 < 16; i0 += 8) {
        half_t s1h[8], gth[8];
#pragma unroll
        for (int i = 0; i < 8; ++i) {
          const size_t m = m0 + ACC_ROW(a, i0 + i);
          s1h[i] = P.s1()[m * 512 + n];
          gth[i] = P.proj()[m * NP + C_SG + n];
        }
        asm volatile("" ::: "memory");
#pragma unroll
        for (int i = 0; i < 8; ++i) {
          float v = (float)s1h[i] * sigmoidf_(acc[a][b][i0 + i] + bg) * siluf_((float)gth[i]);
          csw[(a * 32 + ((i0 + i) & 3) + 8 * ((i0 + i) >> 2)) * CS_STRIDE + b * 32] = (half_t)v;
        }
      }
    }
  __syncthreads();
#pragma unroll 2
  for (int i = 0; i < 8; ++i) {
    int c = tid + 256 * i;
    int row = c >> 4, cc = (c & 15) * 8;
    *(half8*)(P.sg() + (size_t)(m0 + row) * 512 + n0 + cc) = *(const half8*)(cs + row * CS_STRIDE + cc);
  }
}

template <int WHICH>
__device__ __forceinline__ void g24_tile(const Params& P, int mt, int nt, char* smem) {
  const int tid = fresh_tid(), lane = tid & 63, wave = tid >> 6;
  const int wm = wave >> 1, wn = wave & 1;
  const int m0 = mt * 128, n0 = nt * 128;
  f32x16 acc[2][2];
#pragma unroll
  for (int a = 0; a < 2; ++a)
#pragma unroll
    for (int b = 0; b < 2; ++b)
#pragma unroll
      for (int i = 0; i < 16; ++i) acc[a][b][i] = 0.f;
  if (WHICH == 0) gemm_loop(P.attg(), 1024, P.wt_att(), 1024, 1024, m0, n0, acc, smem);
  else            gemm_loop(P.sg(), 512, P.wt_ssm(), 512, 512, m0, n0, acc, smem);
  half_t* cs = (half_t*)smem;
#pragma unroll 1
  for (int i = 0; i < 8; ++i) {
    const int c = tid + 256 * i;
    const int row = c >> 4, cc = (c & 15) * 8;
    const half8 gv = *(const half8*)(P.proj() + (size_t)(m0 + row) * NP + C_MG + WHICH * 2048 + n0 + cc);
    const f32x4 ba = *(const f32x4*)(P.b_merge + WHICH * 2048 + n0 + cc), bb4 = *(const f32x4*)(P.b_merge + WHICH * 2048 + n0 + cc + 4);
    asm volatile("" ::: "memory");
    half8 r;
#pragma unroll
    for (int j = 0; j < 8; ++j) r[j] = (half_t)sigmoidf_((float)gv[j] + (j < 4 ? ba[j & 3] : bb4[j & 3]));
    *(half8*)(cs + row * CS_STRIDE + cc) = r;
  }
  __syncthreads();
  half_t* csw = cs + (wm * 64 + 4 * (lane >> 5)) * CS_STRIDE + wn * 64 + (lane & 31);
#pragma unroll
  for (int a = 0; a < 2; ++a)
#pragma unroll
    for (int b = 0; b < 2; ++b) {
#pragma unroll
      for (int i = 0; i < 16; ++i) {
        const int o = (a * 32 + (i & 3) + 8 * (i >> 2)) * CS_STRIDE + b * 32;
        csw[o] = (half_t)(acc[a][b][i] * (float)csw[o]);
      }
      asm volatile("" ::: "memory");
    }
  __syncthreads();
  half_t* mixed = P.h();
#pragma unroll 2
  for (int i = 0; i < 8; ++i) {
    int c = tid + 256 * i;
    int row = c >> 4, cc = (c & 15) * 8;
    half8 v = *(const half8*)(cs + row * CS_STRIDE + cc);
    half_t* dst = mixed + (size_t)(m0 + row) * D + n0 + cc;
    if (WHICH == 1) {
      const half8 pv = *(const half8*)dst;
#pragma unroll
      for (int j = 0; j < 8; ++j) v[j] = (half_t)((float)v[j] + (float)pv[j]);
    }
    *(half8*)dst = v;
  }
}

__device__ __forceinline__ void g5_tile(const Params& P, int mt, int nt, char* smem) {
  const int tid = fresh_tid(), lane = tid & 63, wave = tid >> 6;
  const int wm = wave >> 1, wn = wave & 1;
  const int m0 = mt * 128, n0 = nt * 128;
  f32x16 acc[2][2];
#pragma unroll
  for (int a = 0; a < 2; ++a)
#pragma unroll
    for (int b = 0; b < 2; ++b)
#pragma unroll
      for (int i = 0; i < 16; ++i) acc[a][b][i] = 0.f;
  gemm_loop(P.h(), D, P.wt_out(), D, D, m0, n0, acc, smem);
#pragma unroll
  for (int a = 0; a < 2; ++a)
#pragma unroll
    for (int b = 0; b < 2; ++b) {
      const int n = n0 + ACC_COL(b);
      float xv[16];
#pragma unroll
      for (int i = 0; i < 16; ++i) xv[i] = P.x[(size_t)(m0 + ACC_ROW(a, i)) * D + n];
      asm volatile("" ::: "memory");
#pragma unroll
      for (int i = 0; i < 16; ++i) P.out[(size_t)(m0 + ACC_ROW(a, i)) * D + n] = xv[i] + acc[a][b][i];
    }
}

__device__ __forceinline__ void fn_task(const Params& P, int t) {
  const int tid = fresh_tid(), lane = tid & 63, wave = tid >> 6;
  int row = t * 4 + wave;
  float4* xr = (float4*)(P.out + (size_t)row * D);
  float4 v[8]; float ss = 0.f;
#pragma unroll
  for (int j = 0; j < 8; ++j) { v[j] = xr[j * 64 + lane]; ss += v[j].x * v[j].x + v[j].y * v[j].y + v[j].z * v[j].z + v[j].w * v[j].w; }
  ss = wave_sum(ss);
  float sc = rsqrtf(ss * (1.0f / D) + 1e-6f);
  const float4* g4 = (const float4*)P.g_final;
#pragma unroll
  for (int j = 0; j < 8; ++j) {
    float4 g = g4[j * 64 + lane];
    float4 o; o.x = v[j].x * sc * g.x; o.y = v[j].y * sc * g.y; o.z = v[j].z * sc * g.z; o.w = v[j].w * sc * g.w;
    xr[j * 64 + lane] = o;
  }
}

__device__ __forceinline__ void ssm_local(const Params& P, int item, char* smem, bool final_pass) {
  const int tid = fresh_tid(), lane = tid & 63, wave = tid >> 6;
  const int it = item * 4 + wave;
  const int n = it >> 5, g = it & 31;
  half_t* ub = (half_t*)(smem + wave * 2048);
  half_t* xs = (half_t*)(smem + 8192 + wave * 8192);
  __syncthreads();
  {
    const u32x4* src = (const u32x4*)(P.proj() + (size_t)(n * 64 + lane) * NP + C_U + g * 16);
    u32x4 u0 = src[0], u1 = src[1];
    *(u32x4*)(ub + lane * 16) = u0;
    *(u32x4*)(ub + lane * 16 + 8) = u1;
  }
  const int gp = g * 64 + lane;
  float bre[16], bim[16];
  {
    const float4* b4 = (const float4*)(P.bb() + (size_t)gp * 32);
#pragma unroll
    for (int j = 0; j < 4; ++j) { float4 v = b4[j]; bre[4 * j] = v.x; bre[4 * j + 1] = v.y; bre[4 * j + 2] = v.z; bre[4 * j + 3] = v.w; }
#pragma unroll
    for (int j = 0; j < 4; ++j) { float4 v = b4[4 + j]; bim[4 * j] = v.x; bim[4 * j + 1] = v.y; bim[4 * j + 2] = v.z; bim[4 * j + 3] = v.w; }
  }
  const float lr = P.lam()[gp * 2], li = P.lam()[gp * 2 + 1];
  float xr = 0.f, xi = 0.f;
  if (final_pass) { xr = P.E()[((size_t)n * 2048 + gp) * 2]; xi = P.E()[((size_t)n * 2048 + gp) * 2 + 1]; }
  __syncthreads();
  half8 bf[4];
  float dsk = 0.f;
  if (final_pass) {
#pragma unroll
    for (int ks = 0; ks < 4; ++ks)
      bf[ks] = *(const half8*)(P.cmT() + (size_t)(g * 16 + (lane & 15)) * 128 + ks * 32 + (lane >> 4) * 8);
    dsk = P.ssm_d[g * 16 + (lane & 15)];
  }
#pragma unroll 1
  for (int hb = 0; hb < 2; ++hb) {
#pragma unroll 2
    for (int tl = 0; tl < 32; ++tl) {
      const int tk = hb * 32 + tl;
      half8 ua = *(const half8*)(ub + tk * 16);
      half8 uc = *(const half8*)(ub + tk * 16 + 8);
      float br = 0.f, bi = 0.f;
#pragma unroll
      for (int c = 0; c < 8; ++c) { float uv = (float)ua[c]; br += bre[c] * uv; bi += bim[c] * uv; }
#pragma unroll
      for (int c = 0; c < 8; ++c) { float uv = (float)uc[c]; br += bre[8 + c] * uv; bi += bim[8 + c] * uv; }
      float nr = lr * xr - li * xi + br;
      float ni = lr * xi + li * xr + bi;
      xr = nr; xi = ni;
      if (final_pass) {
        xs[tl * 128 + lane] = (half_t)xr;
        xs[tl * 128 + 64 + lane] = (half_t)xi;
      }
    }
    if (final_pass) {
#pragma unroll
      for (int rt = 0; rt < 2; ++rt) {
        f32x4 y = {0.f, 0.f, 0.f, 0.f};
#pragma unroll
        for (int ks = 0; ks < 4; ++ks) {
          half8 af = *(const half8*)(xs + (rt * 16 + (lane & 15)) * 128 + ks * 32 + (lane >> 4) * 8);
          y = __builtin_amdgcn_mfma_f32_16x16x32_f16(af, bf[ks], y, 0, 0, 0);
        }
#pragma unroll
        for (int i = 0; i < 4; ++i) {
          int tk = hb * 32 + rt * 16 + (lane >> 4) * 4 + i;
          float uv = (float)ub[tk * 16 + (lane & 15)];
          float yv = y[i] + dsk * uv;
          P.s1()[(size_t)(n * 64 + tk) * 512 + g * 16 + (lane & 15)] = (half_t)gelu_tanh(yv);
        }
      }
    }
  }
  if (!final_pass) {
    P.E()[((size_t)n * 2048 + gp) * 2] = xr;
    P.E()[((size_t)n * 2048 + gp) * 2 + 1] = xi;
  }
}

__device__ __forceinline__ void ssm_carry(const Params& P, int blk) {
  const int gp = blk * 256 + fresh_tid();
  float lr = P.lam()[gp * 2], li = P.lam()[gp * 2 + 1];
#pragma unroll
  for (int s = 0; s < 6; ++s) { float nr = lr * lr - li * li; float ni = 2.0f * lr * li; lr = nr; li = ni; }
  float sr = 0.f, si = 0.f;
  float2* Ep = (float2*)P.E();
  for (int n0 = 0; n0 < 256; n0 += 32) {
    float2 e[32];
#pragma unroll
    for (int u = 0; u < 32; ++u) e[u] = Ep[(size_t)(n0 + u) * 2048 + gp];
    asm volatile("" ::: "memory");
#pragma unroll
    for (int u = 0; u < 32; ++u) {
      Ep[(size_t)(n0 + u) * 2048 + gp] = make_float2(sr, si);
      float nr = lr * sr - li * si + e[u].x;
      float ni = lr * si + li * sr + e[u].y;
      sr = nr; si = ni;
    }
  }
}

constexpr int QROW = 2080;

__device__ __forceinline__ void idx_score_item(const Params& P, int band, int item, char* smem) {
  const int tid = fresh_tid(), lane = tid & 63, wave = tid >> 6;
  const int nqt = band_rows(band) >> 4;
  const int qt = item % nqt, piece = item / nqt;
  const int q0 = band_q0(band) + qt * 16;
  const int sstride = band_stride(band);
  const int nadm = 64 * ((q0 >> 6) + 1);
  const int k0 = piece * KP;
  if (k0 >= nadm) return;
  const int kend = min(k0 + KP, nadm);
  __syncthreads();
  {
    u32x4 qv[8];
#pragma unroll
    for (int i = 0; i < 8; ++i) {
      const int c = tid + 256 * i;
      qv[i] = *(const u32x4*)(P.proj() + (size_t)(q0 + (c >> 7)) * NP + C_QI + (c & 127) * 8);
    }
    asm volatile("" ::: "memory");
#pragma unroll
    for (int i = 0; i < 8; ++i) {
      const int c = tid + 256 * i;
      *(u32x4*)(smem + (c >> 7) * QROW + (c & 127) * 16) = qv[i];
    }
  }
  float* wl = (float*)(smem + 16 * QROW);
  if (tid < 32) {
    const half8 wv = *(const half8*)(P.proj() + (size_t)(q0 + (tid & 15)) * NP + C_WI + (tid >> 4) * 8);
#pragma unroll
    for (int j = 0; j < 8; ++j) wl[((tid >> 4) * 8 + j) * 16 + (tid & 15)] = (float)wv[j];
  }
  __syncthreads();
  const int rt0 = qt * 16, spl = band_split(band);
  float* Sb = (rt0 < spl) ? (P.out + (size_t)rt0 * sstride) : ((float*)P.h() + (size_t)(rt0 - spl) * sstride);
  const char* qbase = smem + (lane & 15) * QROW + (lane >> 4) * 16;
  for (int slab = k0 + wave * 64; slab < kend; slab += 256) {
    half8 kf[4][2];
#pragma unroll
    for (int st = 0; st < 4; ++st)
#pragma unroll
      for (int ks = 0; ks < 2; ++ks)
        kf[st][ks] = *(const half8*)(P.kidx() + (size_t)(slab + st * 16 + (lane & 15)) * 64 + ks * 32 + (lane >> 4) * 8);
    f32x4 acc[4];
#pragma unroll
    for (int st = 0; st < 4; ++st) acc[st] = f32x4{0.f, 0.f, 0.f, 0.f};
#pragma unroll 1
    for (int h = 0; h < 16; ++h) {
      const float wh = wl[h * 16 + (lane & 15)];
      const half8 q0f = *(const half8*)(qbase + h * 128);
      const half8 q1f = *(const half8*)(qbase + h * 128 + 64);
      f32x4 lg[4];
#pragma unroll
      for (int st = 0; st < 4; ++st) {
        lg[st] = f32x4{0.f, 0.f, 0.f, 0.f};
        lg[st] = __builtin_amdgcn_mfma_f32_16x16x32_f16(kf[st][0], q0f, lg[st], 0, 0, 0);
        lg[st] = __builtin_amdgcn_mfma_f32_16x16x32_f16(kf[st][1], q1f, lg[st], 0, 0, 0);
      }
#pragma unroll
      for (int st = 0; st < 4; ++st)
#pragma unroll
        for (int i = 0; i < 4; ++i) {
          float rl = __int_as_float(max(__float_as_int(lg[st][i]), 0));
          asm("" : "+v"(rl));
          acc[st][i] = __builtin_fmaf(rl, wh, acc[st][i]);
        }
    }
    float* srow = Sb + (size_t)(lane & 15) * sstride + slab + 4 * (lane >> 4);
#pragma unroll
    for (int st = 0; st < 4; ++st) *(f32x4*)(srow + st * 16) = acc[st];
  }
}

__device__ __forceinline__ unsigned mono_key(float f) {
  unsigned u = __float_as_uint(f);
  return (u & 0x80000000u) ? ~u : (u | 0x80000000u);
}

__device__ __forceinline__ int wave_scan_add_i(int v) {
  v += __builtin_amdgcn_update_dpp(0, v, 0x111, 0xf, 0xf, true);
  v += __builtin_amdgcn_update_dpp(0, v, 0x112, 0xf, 0xf, true);
  v += __builtin_amdgcn_update_dpp(0, v, 0x114, 0xf, 0xf, true);
  v += __builtin_amdgcn_update_dpp(0, v, 0x118, 0xf, 0xf, true);
  v += __builtin_amdgcn_update_dpp(0, v, 0x142, 0xa, 0xf, false);
  v += __builtin_amdgcn_update_dpp(0, v, 0x143, 0xc, 0xf, false);
  return v;
}

template <int NV, int R>
__device__ __forceinline__ void select_rows(const float* __restrict__ S0, int sstride, int n, unsigned short* __restrict__ sel0,
                                            int* red, int tid, int lane, int wave) {
  unsigned v[R][NV];
#pragma unroll
  for (int r = 0; r < R; ++r)
#pragma unroll
    for (int j = 0; j < NV; ++j)
      v[r][j] = __float_as_uint(S0[(size_t)r * sstride + j * 256 + tid]);
  asm volatile("" ::: "memory");
#pragma unroll
  for (int r = 0; r < R; ++r)
#pragma unroll
    for (int j = 0; j < NV; ++j) {
      const unsigned u = v[r][j];
      const unsigned k = (u & 0x80000000u) ? ~u : (u | 0x80000000u);
      v[r][j] = (j * 256 + tid < n) ? k : 0u;
    }
  unsigned T[R], thr[R]; bool done[R];
#pragma unroll
  for (int r = 0; r < R; ++r) { T[r] = 0u; thr[r] = 0u; done[r] = false; }
  for (int bit = 31; bit >= 0; --bit) {
    int* slot = red + ((bit & 1) << 4);
#pragma unroll
    for (int r = 0; r < R; ++r) {
      if (!done[r]) {
        const unsigned cand = T[r] | (1u << bit);
        int cnt = 0;
#pragma unroll
        for (int j = 0; j < NV; ++j) cnt += (v[r][j] >= cand) ? 1 : 0;
        cnt = wave_scan_add_i(cnt);
        if (lane == 63) slot[r * 4 + wave] = cnt;
      }
    }
    __syncthreads();
    bool all_done = true;
#pragma unroll
    for (int r = 0; r < R; ++r) {
      if (!done[r]) {
        const int total = slot[r * 4] + slot[r * 4 + 1] + slot[r * 4 + 2] + slot[r * 4 + 3];
        if (total >= 256) { T[r] |= (1u << bit); if (total == 256) { done[r] = true; thr[r] = T[r]; } }
      }
      all_done = all_done && done[r];
    }
    if (all_done) break;
  }
  const unsigned long long lt = (lane == 0) ? 0ull : (~0ull >> (64 - lane));
  int* pre = red + 32;
#pragma unroll
  for (int r = 0; r < R; ++r) {
    const bool exact = done[r];
    const unsigned th = exact ? thr[r] : (T[r] + 1u);
    int cl = 0;
#pragma unroll
    for (int j = 0; j < NV; ++j) cl += (v[r][j] >= th) ? 1 : 0;
    const int incl = wave_scan_add_i(cl);
    const int wtot = __builtin_amdgcn_readlane(incl, 63);
    __syncthreads();
    if (lane == 0) pre[wave] = wtot;
    __syncthreads();
    int base = incl - cl, tot = 0;
#pragma unroll
    for (int w2 = 0; w2 < 4; ++w2) { int c = pre[w2]; if (w2 < wave) base += c; tot += c; }
    unsigned short* selq = sel0 + (size_t)r * 256;
#pragma unroll
    for (int j = 0; j < NV; ++j) {
      if (v[r][j] >= th) { selq[base] = (unsigned short)(j * 256 + tid); ++base; }
    }
    if (!exact && wave == 0) {
      const int need_eq = 256 - tot;
      const float* S = S0 + (size_t)r * sstride;
      int filled = 0;
      for (int i0 = 0; i0 < n && filled < need_eq; i0 += 64) {
        const unsigned key = mono_key(S[i0 + lane]);
        const bool e = (key == T[r]);
        const unsigned long long m = __ballot(e);
        const int pos = filled + __popcll(m & lt);
        if (e && pos < need_eq) selq[tot + pos] = (unsigned short)(i0 + lane);
        filled += __popcll(m);
      }
    }
  }
}

__device__ __forceinline__ void idx_select_group(const Params& P, int band, int grp, char* smem) {
  const int tid = fresh_tid(), lane = tid & 63, wave = tid >> 6;
  const int r0 = grp * 4;
  const int q0 = band_q0(band) + r0;
  const int sstride = band_stride(band);
  const int n = 64 * ((q0 >> 6) + 1);
  unsigned short* sel0 = P.sel() + (size_t)q0 * 256;
  if (n <= 256) {
#pragma unroll
    for (int r = 0; r < 4; ++r) sel0[r * 256 + tid] = (unsigned short)(tid < n ? tid : 0);
    return;
  }
  int* red = (int*)smem;
  const int spl = band_split(band);
  const float* S0 = (r0 < spl) ? (P.out + (size_t)r0 * sstride) : ((const float*)P.h() + (size_t)(r0 - spl) * sstride);
  const int nfull = (n + 255) >> 8;
  if (nfull <= 8) select_rows<8, 4>(S0, sstride, n, sel0, red, tid, lane, wave);
  else if (nfull <= 16) select_rows<16, 4>(S0, sstride, n, sel0, red, tid, lane, wave);
  else if (nfull <= 24) {
    select_rows<24, 2>(S0, sstride, n, sel0, red, tid, lane, wave);
    __syncthreads();
    select_rows<24, 2>(S0 + 2 * (size_t)sstride, sstride, n, sel0 + 512, red, tid, lane, wave);
  } else if (nfull <= 32) {
    select_rows<32, 2>(S0, sstride, n, sel0, red, tid, lane, wave);
    __syncthreads();
    select_rows<32, 2>(S0 + 2 * (size_t)sstride, sstride, n, sel0 + 512, red, tid, lane, wave);
  } else if (nfull <= 48) {
#pragma unroll 1
    for (int r = 0; r < 4; ++r) {
      select_rows<48, 1>(S0 + r * (size_t)sstride, sstride, n, sel0 + r * 256, red, tid, lane, wave);
      __syncthreads();
    }
  } else {
#pragma unroll 1
    for (int r = 0; r < 4; ++r) {
      select_rows<64, 1>(S0 + r * (size_t)sstride, sstride, n, sel0 + r * 256, red, tid, lane, wave);
      __syncthreads();
    }
  }
}

__device__ __forceinline__ void attn_item(const Params& P, int item, char* smem) {
  const int tid = fresh_tid(), lane = tid & 63, wave = tid >> 6;
  const int gw = item * 4 + wave;
  const int q = gw >> 1, kvh = gw & 1;
  const int nsel = min(256, 64 * ((q >> 6) + 1));
  char* wsm = smem + wave * 6144;
  unsigned short* sidx = (unsigned short*)wsm;
  float* pbuf = (float*)(wsm + 512);
  float* psum = (float*)(wsm + 512 + 4096);
  __syncthreads();
  *(uint2*)(sidx + lane * 4) = *(const uint2*)(P.sel() + (size_t)q * 256 + lane * 4);
  const int hn = lane & 15, kg = lane >> 4;
  half8 qf[4];
#pragma unroll
  for (int ks = 0; ks < 4; ++ks) {
    half8 z = *(const half8*)(P.proj() + (size_t)q * NP + C_Q + (kvh * 4 + (hn & 3)) * 128 + ks * 32 + kg * 8);
    if (hn >= 4) {
#pragma unroll
      for (int j = 0; j < 8; ++j) z[j] = (half_t)0.f;
    }
    qf[ks] = z;
  }
  __syncthreads();
  const float scale = 0.08838834764831845f;
  float mx = -INFINITY;
#pragma unroll
  for (int tg = 0; tg < 8; ++tg) {
    half8 kf[2][4];
#pragma unroll
    for (int t = 0; t < 2; ++t) {
      const int idx = sidx[(tg * 2 + t) * 16 + hn];
      const half_t* kp = P.proj() + (size_t)idx * NP + C_K + kvh * 128 + kg * 8;
#pragma unroll
      for (int ks = 0; ks < 4; ++ks) kf[t][ks] = *(const half8*)(kp + ks * 32);
    }
    asm volatile("" ::: "memory");
#pragma unroll
    for (int t = 0; t < 2; ++t) {
      f32x4 sv = {0.f, 0.f, 0.f, 0.f};
#pragma unroll
      for (int ks = 0; ks < 4; ++ks) sv = __builtin_amdgcn_mfma_f32_16x16x32_f16(kf[t][ks], qf[ks], sv, 0, 0, 0);
#pragma unroll
      for (int i = 0; i < 4; ++i) {
        const int slot = (tg * 2 + t) * 16 + kg * 4 + i;
        const float x = (slot < nsel) ? sv[i] * scale : -INFINITY;
        mx = fmaxf(mx, x);
        if (hn < 4) pbuf[slot * 4 + hn] = x;
      }
    }
  }
  mx = fmaxf(mx, __shfl_xor(mx, 16, 64));
  mx = fmaxf(mx, __shfl_xor(mx, 32, 64));
  float sum = 0.f;
  if (hn < 4) {
#pragma unroll 4
    for (int t = 0; t < 16; ++t)
#pragma unroll
      for (int i = 0; i < 4; ++i) {
        const int slot = t * 16 + kg * 4 + i;
        const float p = __expf(pbuf[slot * 4 + hn] - mx);
        sum += p;
        pbuf[slot * 4 + hn] = p;
      }
  }
  sum += __shfl_xor(sum, 16, 64);
  sum += __shfl_xor(sum, 32, 64);
  if (lane < 4) psum[lane] = sum;
  __syncthreads();
  float o[4][8];
#pragma unroll
  for (int h = 0; h < 4; ++h)
#pragma unroll
    for (int d = 0; d < 8; ++d) o[h][d] = 0.f;
  const half_t* vbase = P.proj() + C_V + kvh * 128 + hn * 8;
  const int nq = nsel >> 2;
  for (int i0 = 0; i0 < nq; i0 += 4) {
    half8 vv[4];
#pragma unroll
    for (int u = 0; u < 4; ++u) {
      const int idx = sidx[4 * (i0 + u) + kg];
      vv[u] = *(const half8*)(vbase + (size_t)idx * NP);
    }
    asm volatile("" ::: "memory");
#pragma unroll
    for (int u = 0; u < 4; ++u) {
      const float4 p4 = *(const float4*)(pbuf + (4 * (i0 + u) + kg) * 4);
#pragma unroll
      for (int d = 0; d < 8; ++d) {
        const float vf = (float)vv[u][d];
        o[0][d] += p4.x * vf; o[1][d] += p4.y * vf; o[2][d] += p4.z * vf; o[3][d] += p4.w * vf;
      }
    }
  }
#pragma unroll
  for (int h = 0; h < 4; ++h)
#pragma unroll
    for (int d = 0; d < 8; ++d) {
      float v = o[h][d];
      v += __shfl_xor(v, 16, 64);
      v += __shfl_xor(v, 32, 64);
      o[h][d] = v;
    }
  {
    const int h = kg;
    const float inv = 1.0f / psum[h];
    const int col = (kvh * 4 + h) * 128 + hn * 8;
    const half8 gt = *(const half8*)(P.proj() + (size_t)q * NP + C_AG + col);
    half8 r;
#pragma unroll
    for (int d = 0; d < 8; ++d) {
      const float ov = (h == 0) ? o[0][d] : (h == 1) ? o[1][d] : (h == 2) ? o[2][d] : o[3][d];
      r[d] = (half_t)(ov * inv * siluf_((float)gt[d]));
    }
    *(half8*)(P.attg() + (size_t)q * 1024 + col) = r;
  }
}

#define FOR_TILES_XCD(NT, CALL)                                                          \
  for (int t = bid; t < 128 * (NT); t += nb) { int mt, nt; tile_coords(t, (NT), mt, nt); CALL; }

__device__ __forceinline__ void run_phase(const Params& P, int ph, char* smem) {
  const int nb = gridDim.x, bid = blockIdx.x;
  if (ph == 0) { for (int t = bid; t < T0_TOTAL; t += nb) prep_task(P, t, smem); }
  else if (ph == 1) { FOR_TILES_XCD(NP / 128, g1_tile(P, mt, nt, smem)) }
  else if (ph == 2) { for (int t = bid; t < 2048; t += nb) ssm_local(P, t, smem, false); }
  else if (ph == 3) { if (bid < 8) ssm_carry(P, bid); }
  else if (ph == 4) { for (int t = bid; t < 2048; t += nb) ssm_local(P, t, smem, true); }
  else if (ph == 5) { for (int t = bid; t < 128 * 4; t += nb) { int mt, nt; tile_coords(t, 4, mt, nt); g3_tile(P, mt, nt, smem); } }
  else if (ph < 22) {
    const int b = (ph - 6) >> 1;
    if (((ph - 6) & 1) == 0) {
      const int nitems = 128 * ((BAND * (b + 1)) / KP);
      for (int t = bid; t < nitems; t += nb) idx_score_item(P, b, t, smem);
    } else {
      for (int t = bid; t < BAND / 4; t += nb) { __syncthreads(); idx_select_group(P, b, t, smem); }
    }
  }
  else if (ph == 22) { for (int t = bid; t < L * 2 / 4; t += nb) attn_item(P, t, smem); }
  else if (ph == 23) { FOR_TILES_XCD(16, { g24_tile<0>(P, mt, nt, smem); g24_tile<1>(P, mt, nt, smem); }) }
  else if (ph == 24) { FOR_TILES_XCD(16, g5_tile(P, mt, nt, smem)) }
  else if (ph == 25) { for (int t = bid; t < L / 4; t += nb) fn_task(P, t); }
}

#if !MEGA
template <int PH>
__global__ void __launch_bounds__(256, 3) k_ph(Params P) {
  __shared__ __attribute__((aligned(16))) char smem[SMEM_BYTES];
  run_phase(P, PH, smem);
}
__global__ void __launch_bounds__(256, 3) k_score(Params P, int b) {
  __shared__ __attribute__((aligned(16))) char smem[SMEM_BYTES];
  const int nb = gridDim.x, bid = blockIdx.x;
  const int nitems = 128 * ((BAND * (b + 1)) / KP);
  for (int t = bid; t < nitems; t += nb) idx_score_item(P, b, t, smem);
}
__global__ void __launch_bounds__(256, 3) k_select(Params P, int b) {
  __shared__ __attribute__((aligned(16))) char smem[SMEM_BYTES];
  const int nb = gridDim.x, bid = blockIdx.x;
  for (int t = bid; t < BAND / 4; t += nb) { __syncthreads(); idx_select_group(P, b, t, smem); }
}

#endif
#if MEGA
__global__ void __launch_bounds__(256, 3) k_mega(Params P) {
  __shared__ __attribute__((aligned(16))) char smem[SMEM_BYTES];
  cg::grid_group grid = cg::this_grid();
  __shared__ uint4 xb_words;
  if (threadIdx.x == 0) xb_words = make_uint4(0u, 0u, 0u, 0u);
  __syncthreads();
  XcdBarrier xb = xcd_barrier_post(P.bar(), (volatile LAS unsigned*)&xb_words);
  if (P.out == nullptr) grid.sync();
  const int nb = gridDim.x, bid = blockIdx.x;
  for (int r = 0; r < REP_P0; ++r) { run_phase(P, 0, smem); xcd_barrier(xb); }
  for (int r = 0; r < REP_G1; ++r) { run_phase(P, 1, smem); xcd_barrier(xb); }
  for (int b = 0; b < NBAND; ++b) {
    {
      const int n_sc = (band_rows(b) >> 4) * ((band_q0(b) + band_rows(b) + KP - 1) / KP);
      const int n_ex = (b == 0 || b == 1) ? 2048 : (b == 2 ? 512 : 0);
      const int n_at = (b >= 1) ? (band_rows(b - 1) * 2 / 4) : 0;
      const int at0 = (b >= 1) ? (band_q0(b - 1) * 2 / 4) : 0;
      for (int t = bid; t < n_sc; t += nb) idx_score_item(P, b, t, smem);
      const int r1 = (bid + nb - (n_sc % nb)) % nb;
      if (b == 0) { for (int u = r1; u < n_ex; u += nb) ssm_local(P, u, smem, false); }
      else if (b == 1) { for (int u = r1; u < n_ex; u += nb) ssm_local(P, u, smem, true); }
      else if (b == 2) { for (int u = r1; u < n_ex; u += nb) { int mt, nt; tile_coords(u, 4, mt, nt); g3_tile(P, mt, nt, smem); } }
      const int r2 = (r1 + nb - (n_ex % nb)) % nb;
      for (int u = r2; u < n_at; u += nb) attn_item(P, at0 + u, smem);
    }
    xcd_barrier(xb);
    if (b == 0 && bid >= nb - 8) ssm_carry(P, bid - (nb - 8));
    else for (int t = bid; t < band_rows(b) / 4; t += (b == 0 ? nb - 8 : nb)) { __syncthreads(); idx_select_group(P, b, t, smem); }
    xcd_barrier(xb);
  }
  for (int t = bid; t < band_rows(NBAND - 1) * 2 / 4; t += nb) attn_item(P, band_q0(NBAND - 1) * 2 / 4 + t, smem);
  xcd_barrier(xb);
  run_phase(P, 23, smem); xcd_barrier(xb);
  for (int r = 0; r < REP_G5; ++r) { run_phase(P, 24, smem); xcd_barrier(xb); }
  run_phase(P, 25, smem);
}
#endif

extern "C" void kernel_launch(void* const* d_in, const int* in_sizes, int n_in, void* d_out, int out_size,
                              void* d_ws, size_t ws_size, hipStream_t stream) {
  Params p{};
  p.x = (const float*)d_in[0]; p.pos = (const int*)d_in[1]; p.g_norm = (const float*)d_in[2];
  p.w_in = (const float*)d_in[3]; p.b_merge = (const float*)d_in[4]; p.a_re = (const float*)d_in[5];
  p.a_im = (const float*)d_in[6]; p.log_dt = (const float*)d_in[7]; p.b_re = (const float*)d_in[8];
  p.b_im = (const float*)d_in[9]; p.c_re = (const float*)d_in[10]; p.c_im = (const float*)d_in[11];
  p.ssm_d = (const float*)d_in[12]; p.w_glu = (const float*)d_in[13]; p.b_glu = (const float*)d_in[14];
  p.w_att_out = (const float*)d_in[15]; p.w_ssm_out = (const float*)d_in[16]; p.w_out = (const float*)d_in[17];
  p.g_final = (const float*)d_in[18];
  p.out = (float*)d_out;
  p.ws = (char*)d_ws;
  size_t off = WS_NEEDED;
  if (off > ws_size) { fprintf(stderr, "workspace too small: need %zu have %zu\n", off, ws_size); return; }
#if MEGA
  static int grid_blocks = 0;
  if (!grid_blocks) {
    int dev = 0, cus = 0, per_cu = 0;
    hipGetDevice(&dev);
    hipDeviceGetAttribute(&cus, hipDeviceAttributeMultiprocessorCount, dev);
    hipOccupancyMaxActiveBlocksPerMultiprocessor(&per_cu, k_mega, 256, 0);
    if (per_cu > 3) per_cu = 3;
    grid_blocks = cus * per_cu;
  }
  hipMemsetAsync(p.bar(), 0, XCD_BAR_WORDS * 4, stream);
  void* args[] = {&p};
  hipError_t e = hipLaunchCooperativeKernel((void*)k_mega, dim3(grid_blocks), dim3(256), args, 0, stream);
  if (e != hipSuccess) fprintf(stderr, "cooperative launch failed: %s (grid %d)\n", hipGetErrorString(e), grid_blocks);
#else
  k_ph<0><<<1024, 256, 0, stream>>>(p);
  k_ph<1><<<512, 256, 0, stream>>>(p);
  k_ph<2><<<512, 256, 0, stream>>>(p);
  k_ph<3><<<8, 256, 0, stream>>>(p);
  k_ph<4><<<512, 256, 0, stream>>>(p);
  k_ph<5><<<512, 256, 0, stream>>>(p);
  for (int b = 0; b < 8; ++b) { k_score<<<512, 256, 0, stream>>>(p, b); k_select<<<1024, 256, 0, stream>>>(p, b); }
  k_ph<22><<<1024, 256, 0, stream>>>(p);
  k_ph<23><<<512, 256, 0, stream>>>(p);
  k_ph<24><<<512, 256, 0, stream>>>(p);
  k_ph<25><<<1024, 256, 0, stream>>>(p);
#endif
}
```
